# Optimizing an MI355X kernel written in HIP

```python
import math
import jax, jax.numpy as jnp
from jax import lax
import numpy as np

D_MODEL = 1024
BATCH = 2
SEQ = 8192
DEPTH = 4

GRID_W = 64
CTX_LEN = 256
N_MIXERS = 2
N_ATTN_LAYERS = (DEPTH + 1) // 2
N_HYENA_LAYERS = DEPTH // 2
N_HEADS = 16
N_KV_HEADS = 4
HEAD_DIM = D_MODEL // N_HEADS
KV_GROUP = N_HEADS // N_KV_HEADS
ROPE_THETA = 10000.0
Q_BLOCK = 128
D_FF = 256 * ((8 * D_MODEL // 3 + 255) // 256)
HYENA_ORDER = 2
HYENA_DIRS = 2
SHORT_CONV = 3
FILTER_BANDS = 16
FILTER_EMB = 1 + 2 * FILTER_BANDS
FILTER_HIDDEN = 64
DECAY_TARGET = 1e-2
FAST_DECAY_PCT = 0.3
SLOW_DECAY_PCT = 1.5
N_MOD = 9
EPS = 1e-6

kernel_name = "hybrid_gqa_hyena_macaron_dit"


def rms_norm(x, w):
    xf = x.astype(jnp.float32)
    y = xf * lax.rsqrt(jnp.mean(xf * xf, axis=-1, keepdims=True) + EPS)
    return (y * w.astype(jnp.float32)).astype(x.dtype)


def modulate(x, g, shift, scale):
    return rms_norm(x, g) * (1 + scale) + shift


def swiglu(h, w_gu, w_down):
    g, u = jnp.split(h @ w_gu, 2, axis=-1)
    return (jax.nn.silu(g) * u) @ w_down


def ffn_sublayer(s, mod, k, norm_g, w_gu, w_down):
    h = modulate(s, norm_g, mod[3 * k], mod[3 * k + 1])
    return s + 0.5 * mod[3 * k + 2] * swiglu(h, w_gu, w_down)


def grid_positions(n):
    n_rows = n // GRID_W
    rows = jnp.repeat(jnp.arange(n_rows, dtype=jnp.int32), GRID_W)
    cols = jnp.tile(jnp.arange(GRID_W, dtype=jnp.int32), n_rows)
    return rows, cols


def rope_axis(x, pos):
    half = x.shape[-1] // 2
    freqs = ROPE_THETA ** (-jnp.arange(half, dtype=jnp.float32) / half)
    ang = pos.astype(jnp.float32)[:, None] * freqs
    cos = jnp.cos(ang)[:, None, :].astype(x.dtype)
    sin = jnp.sin(ang)[:, None, :].astype(x.dtype)
    x1, x2 = x[..., :half], x[..., half:]
    return jnp.concatenate([x1 * cos - x2 * sin, x1 * sin + x2 * cos], axis=-1)


def rope_2d(x, rows, cols):
    h = x.shape[-1] // 2
    return jnp.concatenate([rope_axis(x[..., :h], rows), rope_axis(x[..., h:], cols)], axis=-1)


def qkv_heads(h, w_qkv, q_norm, k_norm):
    B, L, _ = h.shape
    nq, nk = N_HEADS * HEAD_DIM, N_KV_HEADS * HEAD_DIM
    qkv = h @ w_qkv
    q = qkv[..., :nq].reshape(B, L, N_HEADS, HEAD_DIM)
    k = qkv[..., nq:nq + nk].reshape(B, L, N_KV_HEADS, HEAD_DIM)
    v = qkv[..., nq + nk:].reshape(B, L, N_KV_HEADS, HEAD_DIM)
    return rms_norm(q, q_norm), rms_norm(k, k_norm), v


def gqa(q, k, v):
    B, Lq = q.shape[0], q.shape[1]
    q = q.reshape(B, Lq, N_KV_HEADS, KV_GROUP, HEAD_DIM) * (HEAD_DIM ** -0.5)
    s = jnp.einsum('bqkgd,bnkd->bkgqn', q, k, preferred_element_type=jnp.float32)
    p = jax.nn.softmax(s, axis=-1).astype(v.dtype)
    o = jnp.einsum('bkgqn,bnkd->bqkgd', p, v)
    return o.reshape(B, Lq, N_HEADS * HEAD_DIM)


def attention_mixer(h_lat, h_ctx, w_qkv, w_o, q_norm, k_norm, with_ctx_out):
    B, S, _ = h_lat.shape
    rows, cols = grid_positions(S)
    q_l, k_l, v_l = qkv_heads(h_lat, w_qkv, q_norm, k_norm)
    q_l = rope_2d(q_l, rows, cols)
    k_l = rope_2d(k_l, rows, cols)
    q_c, k_c, v_c = qkv_heads(h_ctx, w_qkv, q_norm, k_norm)
    k_all = jnp.concatenate([k_c, k_l], axis=1)
    v_all = jnp.concatenate([v_c, v_l], axis=1)
    n_blk = S // Q_BLOCK
    q_blocks = q_l.reshape(B, n_blk, Q_BLOCK, N_HEADS, HEAD_DIM).swapaxes(0, 1)
    o_blocks = lax.map(lambda qb: gqa(qb, k_all, v_all), q_blocks)
    o_lat = o_blocks.swapaxes(0, 1).reshape(B, S, N_HEADS * HEAD_DIM) @ w_o
    o_ctx = gqa(q_c, k_c, v_c) @ w_o if with_ctx_out else None
    return o_lat, o_ctx


def hyena_filters(L, f_w1, f_b1, f_w2, f_b2, f_w3, f_b3, f_wout, f_freq):
    f32 = jnp.float32
    t = jnp.linspace(0.0, 1.0, L, dtype=f32)[:, None]
    w = 2.0 * math.pi * jnp.arange(L, dtype=f32)[:, None] / L
    bands = jnp.linspace(1e-4, FILTER_BANDS - 1, FILTER_BANDS, dtype=f32)
    feats = jnp.concatenate([t, jnp.cos(bands * w), -jnp.sin(bands * w)], axis=-1)
    a = f_freq.astype(f32)
    hid = jnp.sin(a * (feats @ f_w1.astype(f32) + f_b1.astype(f32)))
    hid = jnp.sin(a * (hid @ f_w2.astype(f32) + f_b2.astype(f32)))
    hid = jnp.sin(a * (hid @ f_w3.astype(f32) + f_b3.astype(f32)))
    filt = (hid @ f_wout.astype(f32)).reshape(L, HYENA_ORDER, HYENA_DIRS, D_MODEL)
    min_decay = math.log(DECAY_TARGET) / SLOW_DECAY_PCT
    max_decay = math.log(DECAY_TARGET) / FAST_DECAY_PCT
    deltas = jnp.abs(jnp.linspace(min_decay, max_decay, D_MODEL, dtype=f32))
    decay = jnp.exp(-t * deltas)
    return filt * decay[:, None, None, :]


def bidir_filter_taps(filt_o):
    fwd, bwd = filt_o[:, 0], filt_o[:, 1]
    zero = jnp.zeros((1, fwd.shape[-1]), fwd.dtype)
    return jnp.concatenate([fwd[:1] + bwd[:1], fwd[1:], zero, bwd[:0:-1]], axis=0)


def fft_conv(z, taps, bias):
    L = z.shape[1]
    zf = z.astype(jnp.float32)
    zq = jnp.fft.rfft(zf, n=2 * L, axis=1)
    tq = jnp.fft.rfft(taps, n=2 * L, axis=0)[None]
    y = jnp.fft.irfft(zq * tq, n=2 * L, axis=1)[:, :L]
    return (y + zf * bias.astype(jnp.float32)).astype(z.dtype)


def short_conv(u, w, b):
    up = jnp.pad(u, ((0, 0), (1, 1), (0, 0)))
    return up[:, :-2] * w[0] + up[:, 1:-1] * w[1] + up[:, 2:] * w[2] + b


def hyena_mixer(h, w_in, b_in, conv_w, conv_b, f_w1, f_b1, f_w2, f_b2, f_w3, f_b3, f_wout, f_freq, f_bias, w_out, b_out):
    L = h.shape[1]
    u = short_conv(h @ w_in + b_in, conv_w, conv_b)
    v, x1, x2 = jnp.split(u, 3, axis=-1)
    filt = hyena_filters(L, f_w1, f_b1, f_w2, f_b2, f_w3, f_b3, f_wout, f_freq)
    z = x1 * fft_conv(v, bidir_filter_taps(filt[:, 0]), f_bias[0])
    y = x2 * fft_conv(z, bidir_filter_taps(filt[:, 1]), f_bias[1])
    return y @ w_out + b_out


def setup_inputs(seed: int = 0) -> dict:
    key = jax.random.key(seed)
    ks = iter(jax.random.split(key, 32))
    f32 = jnp.float32

    def nrm(shape, scale):
        return jax.random.normal(next(ks), shape, f32) * scale

    D, F = D_MODEL, D_FF
    QKV = (N_HEADS + 2 * N_KV_HEADS) * HEAD_DIM
    nA, nH = N_ATTN_LAYERS, N_HYENA_LAYERS
    FH = FILTER_HIDDEN
    return {
        "x": nrm((BATCH, SEQ, D), 1.0),
        "c": nrm((BATCH, D), 1.0),
        "ctx": nrm((BATCH, CTX_LEN, D), 1.0),
        "c_ctx": nrm((D,), 1.0),
        "w_mod": nrm((DEPTH, D, N_MOD * D), 0.5 * D ** -0.5),
        "b_mod": nrm((DEPTH, N_MOD * D), 0.02),
        "norm_w": 1.0 + nrm((DEPTH, 3, D), 0.05),
        "ffn_w_gate_up": nrm((DEPTH, 2, D, 2 * F), D ** -0.5),
        "ffn_w_down": nrm((DEPTH, 2, F, D), F ** -0.5),
        "attn_w_qkv": nrm((nA, D, QKV), D ** -0.5),
        "attn_w_o": nrm((nA, N_HEADS * HEAD_DIM, D), (N_HEADS * HEAD_DIM) ** -0.5),
        "attn_q_norm": 1.0 + nrm((nA, HEAD_DIM), 0.05),
        "attn_k_norm": 1.0 + nrm((nA, HEAD_DIM), 0.05),
        "hy_w_in": nrm((nH, D, 3 * D), D ** -0.5),
        "hy_b_in": nrm((nH, 3 * D), 0.02),
        "hy_conv_w": nrm((nH, SHORT_CONV, 3 * D), SHORT_CONV ** -0.5),
        "hy_conv_b": nrm((nH, 3 * D), 0.02),
        "hy_f_w1": nrm((nH, FILTER_EMB, FH), FILTER_EMB ** -0.5),
        "hy_f_b1": nrm((nH, FH), 0.1),
        "hy_f_w2": nrm((nH, FH, FH), FH ** -0.5),
        "hy_f_b2": nrm((nH, FH), 0.1),
        "hy_f_w3": nrm((nH, FH, FH), FH ** -0.5),
        "hy_f_b3": nrm((nH, FH), 0.1),
        "hy_f_wout": nrm((nH, FH, HYENA_ORDER * HYENA_DIRS * D), 0.03 * FH ** -0.5),
        "hy_f_freq": 1.0 + nrm((nH, FH), 0.05),
        "hy_f_bias": nrm((nH, HYENA_ORDER, D), 0.5),
        "hy_w_out": nrm((nH, D, D), D ** -0.5),
        "hy_b_out": nrm((nH, D), 0.02),
    }


def reference(x, c, ctx, c_ctx, w_mod, b_mod, norm_w, ffn_w_gate_up, ffn_w_down,
              attn_w_qkv, attn_w_o, attn_q_norm, attn_k_norm,
              hy_w_in, hy_b_in, hy_conv_w, hy_conv_b, hy_f_w1, hy_f_b1, hy_f_w2, hy_f_b2,
              hy_f_w3, hy_f_b3, hy_f_wout, hy_f_freq, hy_f_bias, hy_w_out, hy_b_out):
    B, D = x.shape[0], x.shape[-1]
    for l in range(DEPTH):
        mod_x = (jax.nn.silu(c) @ w_mod[l] + b_mod[l]).reshape(B, N_MOD, 1, D).swapaxes(0, 1)
        mod_c = (jax.nn.silu(c_ctx) @ w_mod[l] + b_mod[l]).reshape(N_MOD, 1, 1, D)
        is_attn = (l % N_MIXERS) == 0
        ctx_out = l < DEPTH - 1
        ctx_live = ctx_out or is_attn

        x = ffn_sublayer(x, mod_x, 0, norm_w[l, 0], ffn_w_gate_up[l, 0], ffn_w_down[l, 0])
        if ctx_live:
            ctx = ffn_sublayer(ctx, mod_c, 0, norm_w[l, 0], ffn_w_gate_up[l, 0], ffn_w_down[l, 0])

        h_x = modulate(x, norm_w[l, 1], mod_x[3], mod_x[4])
        if is_attn:
            a = l // N_MIXERS
            h_c = modulate(ctx, norm_w[l, 1], mod_c[3], mod_c[4])
            o_x, o_c = attention_mixer(h_x, h_c, attn_w_qkv[a], attn_w_o[a],
                                       attn_q_norm[a], attn_k_norm[a], ctx_out)
        else:
            j = l // N_MIXERS
            hp = (hy_w_in[j], hy_b_in[j], hy_conv_w[j], hy_conv_b[j], hy_f_w1[j], hy_f_b1[j],
                  hy_f_w2[j], hy_f_b2[j], hy_f_w3[j], hy_f_b3[j], hy_f_wout[j], hy_f_freq[j],
                  hy_f_bias[j], hy_w_out[j], hy_b_out[j])
            o_x = hyena_mixer(h_x, *hp)
            o_c = hyena_mixer(modulate(ctx, norm_w[l, 1], mod_c[3], mod_c[4]), *hp) if ctx_out else None
        x = x + mod_x[5] * o_x
        if ctx_out:
            ctx = ctx + mod_c[5] * o_c

        x = ffn_sublayer(x, mod_x, 2, norm_w[l, 2], ffn_w_gate_up[l, 1], ffn_w_down[l, 1])
        if ctx_out:
            ctx = ffn_sublayer(ctx, mod_c, 2, norm_w[l, 2], ffn_w_gate_up[l, 1], ffn_w_down[l, 1])
    return x
```

```cpp
#include <hip/hip_runtime.h>
#include <hip/hip_cooperative_groups.h>
#include <cstdio>
#include <cstdint>
namespace cg = cooperative_groups;

typedef unsigned short bf16_t;
typedef __attribute__((ext_vector_type(8))) short bf16x8;
typedef __attribute__((ext_vector_type(4))) float f32x4;
typedef __attribute__((ext_vector_type(16))) float f32x16;
typedef __attribute__((ext_vector_type(4))) unsigned u32x4;
typedef __attribute__((ext_vector_type(2))) float f32x2;

#define NTHR 512
#ifndef PROBE_MASK
#define PROBE_MASK 0
#endif
constexpr int D = 1024, FF = 2816, NGU = 5632, SEQ = 8192, CTXL = 256, MLAT = 16384, MALL = 16896, NKEY = 8448;
constexpr float EPSN = 1e-6f;

constexpr size_t OFF_BAR = 0;
constexpr size_t OFF_MOD = 16384;
constexpr size_t OFF_HID3 = OFF_MOD + 442368;
constexpr size_t OFF_HID3C = OFF_HID3 + 2097152;
constexpr size_t OFF_WOUTT = OFF_HID3C + 131072;
constexpr size_t OFF_WGU = OFF_WOUTT + 1048576;
constexpr size_t OFF_WD = OFF_WGU + 92274688;
constexpr size_t OFF_WQKV = OFF_WD + 46137344;
constexpr size_t OFF_WO = OFF_WQKV + 6291456;
constexpr size_t OFF_WIN = OFF_WO + 4194304;
constexpr size_t OFF_WHO = OFF_WIN + 12582912;
constexpr size_t OFF_S = OFF_WHO + 4194304;
constexpr size_t OFF_HB = OFF_S + 69206016;
constexpr size_t OFF_ACT = OFF_HB + 34603008;
constexpr size_t OFF_Q = OFF_ACT + 95158272;
constexpr size_t OFF_KB = OFF_Q + 34603008;
constexpr size_t OFF_VT = OFF_KB + 8650752;
constexpr size_t OFF_OB = OFF_VT + 8650752;
constexpr size_t OFF_FILT = OFF_OB + 34603008;
constexpr size_t OFF_XS = OFF_FILT + 67108864;
constexpr size_t OFF_PART = OFF_XS + (size_t)512 * 65536;
constexpr size_t OFF_YT = OFF_PART + (size_t)11 * 512 * 1024 * 4;
constexpr size_t WS_END = OFF_YT + (size_t)1024 * 16896 * 2;

struct Params {
  const float* in[28];
  float* out;
  char* ws;
  int ph_lo, ph_hi;
};

__device__ __forceinline__ int tid_() { int t = threadIdx.x; asm volatile("" : "+v"(t)); return t; }
__device__ __forceinline__ bf16_t f2bf(float f) {
  unsigned u = __float_as_uint(f);
  u += 0x7fffu + ((u >> 16) & 1u);
  return (bf16_t)(u >> 16);
}
__device__ __forceinline__ float bf2f(bf16_t h) { return __uint_as_float(((unsigned)h) << 16); }

__device__ __forceinline__ unsigned cvt_pk_bf16(float lo, float hi) { unsigned r; asm volatile("v_cvt_pk_bf16_f32 %0, %1, %2" : "=v"(r) : "v"(lo), "v"(hi)); return r; }
__device__ __forceinline__ unsigned pack2(float a, float b) { return cvt_pk_bf16(a, b); }
__device__ __forceinline__ float silu_f(float x) { return x * __builtin_amdgcn_rcpf(1.f + __expf(-x)); }
__device__ __forceinline__ int swz(int row, int ch) { return row * 128 + ((ch ^ ((row >> 1) & 7)) << 4); }
__device__ __forceinline__ float2 cmul(float2 a, float2 b) { return make_float2(a.x * b.x - a.y * b.y, a.x * b.y + a.y * b.x); }
__device__ __forceinline__ float2 cexp_rev(float rev) { return make_float2(__builtin_amdgcn_cosf(rev), __builtin_amdgcn_sinf(rev)); }

enum { EPI_SWIGLU = 0, EPI_RESID = 1, EPI_QK = 2, EPI_T = 3, EPI_FILT = 4 };

struct Epi {
  float* S; const float* Sin; float* out2; const float* gate; const float* bias; float coef;
  bf16_t* ob; int ldo; int vmode; int atomic; float* part;
  bf16_t* q; bf16_t* kb; const float* qn; const float* kn;
};

__device__ __forceinline__ int swz32(int row, int ch) { return row * 64 + ((ch ^ ((0 - (row >> 2)) & 3)) << 4); }

template <int EPI>
__device__ __forceinline__ void gemm256_tile(const bf16_t* A, const bf16_t* Bt, int ld, int kt0, int nkt, int m0, int n0, char* lds, const Epi& e, int part) {
  const int tid = tid_(), lane = tid & 63, w = __builtin_amdgcn_readfirstlane(tid >> 6);
  const int wm = w >> 2, wn = w & 3;
  const int fr = lane & 15, fq = lane >> 4;
  f32x4 acc[8][4];
#pragma unroll
  for (int i = 0; i < 8; ++i)
#pragma unroll
    for (int j = 0; j < 4; ++j) acc[i][j] = (f32x4){0.f, 0.f, 0.f, 0.f};
  unsigned soff[2];
#pragma unroll
  for (int i = 0; i < 2; ++i) {
    const int r = 16 * (w * 2 + i) + (lane >> 2);
    const int c = (lane & 3) ^ ((0 - (r >> 2)) & 3);
    soff[i] = (unsigned)(r * ld + c * 8);
  }
  const int nks = nkt * 2;
  const bf16_t* Ab = A + (size_t)m0 * ld + (size_t)kt0 * 64;
  const bf16_t* Bb = Bt + (size_t)n0 * ld + (size_t)kt0 * 64;
  char* ldsw = lds + w * 2048;
#define G256_ISSUE(step)                                                                                                        \
  do {                                                                                                                          \
    const int st_ = (step) < nks ? (step) : (nks - 1);                                                                          \
    char* dA_ = ldsw + ((step) & 3) * 32768;                                                                                    \
    const bf16_t* ga_ = Ab + (size_t)st_ * 32;                                                                                  \
    const bf16_t* gb_ = Bb + (size_t)st_ * 32;                                                                                  \
    __builtin_amdgcn_global_load_lds((const unsigned*)(ga_ + soff[0]), (unsigned*)(dA_), 16, 0, 0);                             \
    __builtin_amdgcn_global_load_lds((const unsigned*)(ga_ + soff[1]), (unsigned*)(dA_ + 1024), 16, 0, 0);                      \
    __builtin_amdgcn_global_load_lds((const unsigned*)(gb_ + soff[0]), (unsigned*)(dA_ + 16384), 16, 0, 0);                     \
    __builtin_amdgcn_global_load_lds((const unsigned*)(gb_ + soff[1]), (unsigned*)(dA_ + 16384 + 1024), 16, 0, 0);              \
  } while (0)
  G256_ISSUE(0);
  G256_ISSUE(1);
  G256_ISSUE(2);
  for (int t = 0; t < nks; ++t) {
    asm volatile("s_waitcnt vmcnt(8) lgkmcnt(0)" ::: "memory");
    __builtin_amdgcn_s_barrier();
    asm volatile("" ::: "memory");
    G256_ISSUE(t + 3);
    const char* cA = lds + (t & 3) * 32768;
    const char* cB = cA + 16384;
    bf16x8 bfr[4];
#pragma unroll
    for (int ni = 0; ni < 4; ++ni) bfr[ni] = *(const bf16x8*)(cB + swz32(wn * 64 + ni * 16 + fr, fq));
#pragma unroll
    for (int mh = 0; mh < 2; ++mh) {
      bf16x8 af[4];
#pragma unroll
      for (int mi = 0; mi < 4; ++mi) af[mi] = *(const bf16x8*)(cA + swz32(wm * 128 + (mh * 4 + mi) * 16 + fr, fq));
#pragma unroll
      for (int mi = 0; mi < 4; ++mi)
#pragma unroll
        for (int ni = 0; ni < 4; ++ni)
          acc[mh * 4 + mi][ni] = __builtin_amdgcn_mfma_f32_16x16x32_bf16(bfr[ni], af[mi], acc[mh * 4 + mi][ni], 0, 0, 0);
    }
  }
  asm volatile("s_waitcnt vmcnt(0)" ::: "memory");
  __syncthreads();
#undef G256_ISSUE
  const int rbase = m0 + wm * 128 + fr;
  const int cbase = n0 + wn * 64 + 4 * fq;
  if (EPI == EPI_SWIGLU) {
#pragma unroll
    for (int mi = 0; mi < 8; ++mi) {
      const int rl = wm * 128 + mi * 16 + fr;
#pragma unroll
      for (int nj = 0; nj < 2; ++nj) {
        const int fl = wn * 32 + nj * 16 + 4 * fq;
        const f32x4 g = acc[mi][2 * nj], u = acc[mi][2 * nj + 1];
        uint2 pk;
        pk.x = pack2(silu_f(g[0]) * u[0], silu_f(g[1]) * u[1]);
        pk.y = pack2(silu_f(g[2]) * u[2], silu_f(g[3]) * u[3]);
        *(uint2*)(lds + rl * 272 + fl * 2) = pk;
      }
    }
    __syncthreads();
    {
      bf16_t* dst = e.ob + (size_t)m0 * FF + (n0 >> 1);
#pragma unroll
      for (int i = 0; i < 8; ++i) {
        const int c = tid + 512 * i;
        const int rl = c >> 4, ch = c & 15;
        const uint4 v = *(const uint4*)(lds + rl * 272 + ch * 16);
        *(uint4*)(dst + (size_t)rl * FF + ch * 8) = v;
      }
    }
    __syncthreads();
  } else if (EPI == EPI_RESID) {
    const int grp = (m0 < SEQ) ? 0 : ((m0 < MLAT) ? 1 : 2);
#pragma unroll
    for (int ni = 0; ni < 4; ++ni) {
      const int col = cbase + ni * 16;
      float4 g = *(const float4*)(e.gate + grp * 9216 + col);
      g.x *= e.coef; g.y *= e.coef; g.z *= e.coef; g.w *= e.coef;
      float4 bv = make_float4(0.f, 0.f, 0.f, 0.f);
      if (e.bias && part == 0) bv = *(const float4*)(e.bias + col);
#pragma unroll
      for (int mi = 0; mi < 8; ++mi) {
        const int row = rbase + mi * 16;
        const size_t idx = (size_t)row * D + col;
        const f32x4 a = acc[mi][ni];
        if (e.atomic) {
          float4 o4;
          o4.x = g.x * (a[0] + bv.x); o4.y = g.y * (a[1] + bv.y); o4.z = g.z * (a[2] + bv.z); o4.w = g.w * (a[3] + bv.w);
          *(float4*)(e.part + ((size_t)part * 512 + (row - MLAT)) * D + col) = o4;
        } else {
          float4 s4 = *(const float4*)(e.Sin + idx);
          s4.x += g.x * (a[0] + bv.x); s4.y += g.y * (a[1] + bv.y); s4.z += g.z * (a[2] + bv.z); s4.w += g.w * (a[3] + bv.w);
          *(float4*)(e.S + idx) = s4;
          if (e.out2 && row < MLAT) *(float4*)(e.out2 + idx) = s4;
        }
      }
    }
  } else if (EPI == EPI_QK) {
    const int hcol0 = n0 + wn * 64;
    const bool isq = hcol0 < 1024;
    const float* nw = isq ? e.qn : e.kn;
    float4 nwv[4];
#pragma unroll
    for (int ni = 0; ni < 4; ++ni) nwv[ni] = *(const float4*)(nw + ni * 16 + 4 * fq);
    float freq[4];
#pragma unroll
    for (int i = 0; i < 4; ++i) freq[i] = exp2f(-(float)(4 * fq + i) * (13.287712379549449f / 16.f)) * 0.15915494309189535f;
    const float qs = isq ? (0.125f * 1.4426950408889634f) : 1.f;
#pragma unroll
    for (int mi = 0; mi < 8; ++mi) {
      const int row = rbase + mi * 16;
      f32x4 v[4];
      float ss = 0.f;
#pragma unroll
      for (int ni = 0; ni < 4; ++ni) { v[ni] = acc[mi][ni]; ss += v[ni][0] * v[ni][0] + v[ni][1] * v[ni][1] + v[ni][2] * v[ni][2] + v[ni][3] * v[ni][3]; }
      ss += __shfl_xor(ss, 16); ss += __shfl_xor(ss, 32);
      const float rstd = rsqrtf(ss * (1.f / 64.f) + EPSN);
#pragma unroll
      for (int ni = 0; ni < 4; ++ni) {
        v[ni][0] *= rstd * nwv[ni].x; v[ni][1] *= rstd * nwv[ni].y; v[ni][2] *= rstd * nwv[ni].z; v[ni][3] *= rstd * nwv[ni].w;
      }
      if (row < MLAT) {
        const int t = row & (SEQ - 1);
        const float pr = (float)(t >> 6), pc = (float)(t & 63);
#pragma unroll
        for (int i = 0; i < 4; ++i) {
          const float ar = pr * freq[i], ac = pc * freq[i];
          const float cr = __builtin_amdgcn_cosf(ar), sr = __builtin_amdgcn_sinf(ar);
          const float cc = __builtin_amdgcn_cosf(ac), sc = __builtin_amdgcn_sinf(ac);
          const float a0 = v[0][i] * cr - v[1][i] * sr, a1 = v[0][i] * sr + v[1][i] * cr;
          const float a2 = v[2][i] * cc - v[3][i] * sc, a3 = v[2][i] * sc + v[3][i] * cc;
          v[0][i] = a0; v[1][i] = a1; v[2][i] = a2; v[3][i] = a3;
        }
      }
      bf16_t* dst;
      if (isq) dst = e.q + (size_t)row * D + hcol0 + 4 * fq;
      else {
        const int kvh = (hcol0 - 1024) >> 6;
        int b, pos;
        if (row < MLAT) { b = row >> 13; pos = CTXL + (row & (SEQ - 1)); }
        else { b = (row - MLAT) >> 8; pos = (row - MLAT) & 255; }
        dst = e.kb + ((size_t)(b * 4 + kvh) * NKEY + pos) * 64 + 4 * fq;
      }
#pragma unroll
      for (int ni = 0; ni < 4; ++ni) {
        uint2 pk;
        pk.x = pack2(v[ni][0] * qs, v[ni][1] * qs);
        pk.y = pack2(v[ni][2] * qs, v[ni][3] * qs);
        *(uint2*)(dst + ni * 16) = pk;
      }
    }
  } else if (EPI == EPI_T) {
#pragma unroll
    for (int ni = 0; ni < 4; ++ni) {
      const int tok = cbase + ni * 16;
      size_t cm = (size_t)tok;
      if (e.vmode) {
        int b, pos;
        if (tok < MLAT) { b = tok >> 13; pos = CTXL + (tok & (SEQ - 1)); }
        else { b = (tok - MLAT) >> 8; pos = (tok - MLAT) & 255; }
        cm = (size_t)b * 256 * NKEY + pos;
      }
#pragma unroll
      for (int mi = 0; mi < 8; ++mi) {
        const int row = rbase + mi * 16;
        const float bv = e.bias ? e.bias[row] : 0.f;
        const f32x4 a = acc[mi][ni];
        uint2 pk;
        pk.x = pack2(a[0] + bv, a[1] + bv);
        pk.y = pack2(a[2] + bv, a[3] + bv);
        *(uint2*)(e.ob + (size_t)row * e.ldo + cm) = pk;
      }
    }
  } else if (EPI == EPI_FILT) {
#pragma unroll
    for (int mi = 0; mi < 8; ++mi) {
      const int row = rbase + mi * 16;
      const int d = row & 1023;
      const float delta = fabsf(-3.0701134573253945f + (float)d * ((-15.350567286626973f + 3.0701134573253945f) / 1023.f));
      const float dk = -delta * (1.f / 8191.f);
#pragma unroll
      for (int ni = 0; ni < 4; ++ni) {
        const int t = cbase + ni * 16;
        const f32x4 a = acc[mi][ni];
        uint2 pk;
        pk.x = pack2(a[0] * __expf((float)t * dk), a[1] * __expf((float)(t + 1) * dk));
        pk.y = pack2(a[2] * __expf((float)(t + 2) * dk), a[3] * __expf((float)(t + 3) * dk));
        *(uint2*)(e.ob + (size_t)row * SEQ + t) = pk;
      }
    }
  }
}

template <int EPI>
__device__ __forceinline__ void gemm256_phase(const bf16_t* A, const bf16_t* Bt, int ld, int nkt, int MT, int NTn, char* lds, const Epi& e, int rot) {
  const int G = gridDim.x;
  const int total = MT * NTn;
  int bid = (int)((blockIdx.x + G - (rot % G)) % G);
  if ((G & 7) == 0) bid = (bid & 7) * (G >> 3) + (bid >> 3);
  for (int u = bid; u < total; u += G) {
    const int band = u / (8 * NTn);
    const int rem = u - band * 8 * NTn;
    const int gsz = min(8, MT - band * 8);
    const int nt = rem / gsz, mt = band * 8 + (rem - nt * gsz);
    gemm256_tile<EPI>(A, Bt, ld, 0, nkt, mt * 256, nt * 256, lds, e, 0);
  }
}

__device__ __forceinline__ void convert_matrix(const float* src, int K, int N, bf16_t* dst, int perm, char* lds, int& rot) {
  const int G = gridDim.x, tid = tid_();
  const int tn = N >> 8, tk = K >> 6, total = tn * tk;
  bf16_t* T = (bf16_t*)lds;
  const int kr0 = tid >> 6, c4 = tid & 63;
  int t = (int)((blockIdx.x + G - (rot % G)) % G);
  float4 v[8];
  if (t < total) {
    const int kt = t / tn, ntile = t - kt * tn;
    const float* g = src + (size_t)((kt << 6) + kr0) * N + (ntile << 8) + c4 * 4;
#pragma unroll
    for (int i = 0; i < 8; ++i) v[i] = *(const float4*)(g + (size_t)(8 * i) * N);
  }
  for (; t < total; t += G) {
    const int kt = t / tn, ntile = t - kt * tn;
    const int k0 = kt << 6, n0 = ntile << 8;
#pragma unroll
    for (int i = 0; i < 8; ++i) {
      const int kr = kr0 + 8 * i;
      T[(c4 * 4 + 0) * 72 + kr] = f2bf(v[i].x);
      T[(c4 * 4 + 1) * 72 + kr] = f2bf(v[i].y);
      T[(c4 * 4 + 2) * 72 + kr] = f2bf(v[i].z);
      T[(c4 * 4 + 3) * 72 + kr] = f2bf(v[i].w);
    }
    const int t2 = t + G;
    if (t2 < total) {
      const int kt2 = t2 / tn, nt2 = t2 - kt2 * tn;
      const float* g = src + (size_t)((kt2 << 6) + kr0) * N + (nt2 << 8) + c4 * 4;
#pragma unroll
      for (int i = 0; i < 8; ++i) v[i] = *(const float4*)(g + (size_t)(8 * i) * N);
    }
    __syncthreads();
#pragma unroll
    for (int i = 0; i < 4; ++i) {
      const int idx = tid + 512 * i;
      const int n = idx >> 3, ch = idx & 7;
      const uint4 o = *(const uint4*)(T + n * 72 + ch * 8);
      int ng = n0 + n;
      if (perm) {
        if (ng < FF) ng = ((ng >> 4) << 5) + (ng & 15);
        else { const int f = ng - FF; ng = ((f >> 4) << 5) + 16 + (f & 15); }
      }
      *(uint4*)(dst + (size_t)ng * K + k0 + ch * 8) = o;
    }
    __syncthreads();
  }
  rot += total;
}

__device__ __forceinline__ void p0_prologue(const Params& p, char* lds) {
  const int G = gridDim.x, tid = tid_(), lane = tid & 63, w = tid >> 6;
  char* ws = p.ws;
  {
    float4* S4 = (float4*)(ws + OFF_S);
    const float4* x4 = (const float4*)p.in[0];
    const float4* c4 = (const float4*)p.in[2];
    const size_t nlat = (size_t)MLAT * D / 4, nall = (size_t)MALL * D / 4;
    (void)x4;
    for (size_t i = nlat + (size_t)blockIdx.x * NTHR + tid; i < nall; i += (size_t)G * NTHR)
      S4[i] = c4[i - nlat];
  }
  {
    float* MOD = (float*)(ws + OFF_MOD);
    const float* c = p.in[1];
    const float* cc = p.in[3];
    float* red = (float*)lds;
    for (int it = blockIdx.x; it < 4 * 144; it += G) {
      const int l = it / 144, c0 = (it - l * 144) * 64;
      const int cg4 = lane & 15, kq = lane >> 4;
      float a[3][4];
#pragma unroll
      for (int g = 0; g < 3; ++g)
#pragma unroll
        for (int j = 0; j < 4; ++j) a[g][j] = 0.f;
      const float* wb = p.in[4] + (size_t)l * D * 9216 + c0 + cg4 * 4;
#pragma unroll 4
      for (int i = 0; i < 32; ++i) {
        const int k = w * 128 + i * 4 + kq;
        const float4 wv = *(const float4*)(wb + (size_t)k * 9216);
        const float s0 = silu_f(c[k]), s1 = silu_f(c[D + k]), s2 = silu_f(cc[k]);
        a[0][0] += s0 * wv.x; a[0][1] += s0 * wv.y; a[0][2] += s0 * wv.z; a[0][3] += s0 * wv.w;
        a[1][0] += s1 * wv.x; a[1][1] += s1 * wv.y; a[1][2] += s1 * wv.z; a[1][3] += s1 * wv.w;
        a[2][0] += s2 * wv.x; a[2][1] += s2 * wv.y; a[2][2] += s2 * wv.z; a[2][3] += s2 * wv.w;
      }
#pragma unroll
      for (int g = 0; g < 3; ++g)
#pragma unroll
        for (int j = 0; j < 4; ++j) {
          float v = a[g][j];
          v += __shfl_xor(v, 16); v += __shfl_xor(v, 32);
          a[g][j] = v;
        }
      if (kq == 0) {
#pragma unroll
        for (int g = 0; g < 3; ++g)
#pragma unroll
          for (int j = 0; j < 4; ++j) red[(w * 3 + g) * 64 + cg4 * 4 + j] = a[g][j];
      }
      __syncthreads();
      if (tid < 192) {
        const int g = tid >> 6, col = tid & 63;
        float s = 0.f;
#pragma unroll
        for (int ww = 0; ww < 8; ++ww) s += red[(ww * 3 + g) * 64 + col];
        MOD[(size_t)(l * 3 + g) * 9216 + c0 + col] = s + p.in[5][(size_t)l * 9216 + c0 + col];
      }
      __syncthreads();
    }
  }
  {
    int rot = 0;
    for (int i = 0; i < 8; ++i) convert_matrix(p.in[7] + (size_t)i * D * NGU, D, NGU, (bf16_t*)(ws + OFF_WGU) + (size_t)i * NGU * D, 1, lds, rot);
    for (int i = 0; i < 8; ++i) convert_matrix(p.in[8] + (size_t)i * FF * D, FF, D, (bf16_t*)(ws + OFF_WD) + (size_t)i * D * FF, 0, lds, rot);
    for (int i = 0; i < 2; ++i) convert_matrix(p.in[9] + (size_t)i * D * 1536, D, 1536, (bf16_t*)(ws + OFF_WQKV) + (size_t)i * 1536 * D, 0, lds, rot);
    for (int i = 0; i < 2; ++i) convert_matrix(p.in[10] + (size_t)i * D * D, D, D, (bf16_t*)(ws + OFF_WO) + (size_t)i * D * D, 0, lds, rot);
    for (int i = 0; i < 2; ++i) convert_matrix(p.in[13] + (size_t)i * D * 3072, D, 3072, (bf16_t*)(ws + OFF_WIN) + (size_t)i * 3072 * D, 0, lds, rot);
    for (int i = 0; i < 2; ++i) convert_matrix(p.in[26] + (size_t)i * D * D, D, D, (bf16_t*)(ws + OFF_WHO) + (size_t)i * D * D, 0, lds, rot);
    for (int i = 0; i < 2; ++i) convert_matrix(p.in[23] + (size_t)i * 64 * 4096, 64, 4096, (bf16_t*)(ws + OFF_WOUTT) + (size_t)i * 4096 * 64, 0, lds, rot);
  }
  {
    float* W1 = (float*)lds;
    float* W2 = W1 + 33 * 64;
    float* W3 = W2 + 64 * 64;
    float* feat = W3 + 64 * 64;
    float* h1 = feat + 8 * 40;
    float* h2 = h1 + 8 * 64;
    const int tt = tid >> 6, h = tid & 63;
    const int per = 256 + 8;
    int jcur = -1;
    for (int it = blockIdx.x; it < 2 * per; it += G) {
      const int j = it / per;
      int r = it - j * per;
      const int Lsel = (r >= 256);
      if (Lsel) r -= 256;
      const int L = Lsel ? 256 : 8192;
      if (j != jcur) {
        __syncthreads();
        for (int i = tid; i < 33 * 64; i += NTHR) W1[i] = p.in[17][(size_t)j * 33 * 64 + i];
        for (int i = tid; i < 64 * 64; i += NTHR) { W2[i] = p.in[19][(size_t)j * 4096 + i]; W3[i] = p.in[21][(size_t)j * 4096 + i]; }
        jcur = j;
        __syncthreads();
      }
      const float a = p.in[24][j * 64 + h];
      const float b1 = p.in[18][j * 64 + h], b2 = p.in[20][j * 64 + h], b3 = p.in[22][j * 64 + h];
      for (int sub = 0; sub < 4; ++sub) {
        const int t = r * 32 + sub * 8 + tt;
        if (h < 33) {
          const float tl = (float)t / (float)(L - 1);
          const float wv = (6.2831855f * (float)t) / (float)L;
          float f;
          if (h == 0) f = tl;
          else {
            const int bi = (h - 1) & 15;
            const float band = 1e-4f + (float)bi * ((15.f - 1e-4f) / 15.f);
            const float ang = band * wv;
            f = (h <= 16) ? __cosf(ang) : -__sinf(ang);
          }
          feat[tt * 40 + h] = f;
        }
        __syncthreads();
        {
          float s = b1;
#pragma unroll
          for (int e2 = 0; e2 < 33; ++e2) s += feat[tt * 40 + e2] * W1[e2 * 64 + h];
          h1[tt * 64 + h] = __sinf(a * s);
        }
        __syncthreads();
        {
          float s = b2;
#pragma unroll 16
          for (int k = 0; k < 64; ++k) s += h1[tt * 64 + k] * W2[k * 64 + h];
          h2[tt * 64 + h] = __sinf(a * s);
        }
        __syncthreads();
        {
          float s = b3;
#pragma unroll 16
          for (int k = 0; k < 64; ++k) s += h2[tt * 64 + k] * W3[k * 64 + h];
          const float v = __sinf(a * s);
          if (Lsel) ((float*)(ws + OFF_HID3C))[((size_t)j * 256 + t) * 64 + h] = v;
          else ((bf16_t*)(ws + OFF_HID3))[((size_t)j * 8192 + t) * 64 + h] = f2bf(v);
        }
      }
    }
    __syncthreads();
  }
}

__device__ __forceinline__ void normmod_phase(const Params& p, int l, int k, int rows, int nparts) {
  const int G = gridDim.x, tid = tid_(), lane = tid & 63, w = tid >> 6;
  float* S = (float*)(p.ws + OFF_S);
  const float* PART = (const float*)(p.ws + OFF_PART);
  bf16_t* HB = (bf16_t*)(p.ws + OFF_HB);
  const float* MOD = (const float*)(p.ws + OFF_MOD) + (size_t)l * 3 * 9216;
  const float* nw = p.in[6] + (size_t)(l * 3 + k) * D;
  const int stride = G * 8;
  for (int row0 = blockIdx.x * 8 + w; row0 < rows; row0 += 2 * stride) {
    float4 x[2][4];
    float ss[2] = {0.f, 0.f};
#pragma unroll
    for (int rr = 0; rr < 2; ++rr) {
      const int row = row0 + rr * stride;
      if (row < rows) {
#pragma unroll
        for (int q = 0; q < 4; ++q) x[rr][q] = *(const float4*)(((l == 0 && k == 0 && row < MLAT) ? p.in[0] : (const float*)S) + (size_t)row * D + q * 256 + lane * 4);
      } else {
#pragma unroll
        for (int q = 0; q < 4; ++q) x[rr][q] = make_float4(0.f, 0.f, 0.f, 0.f);
      }
    }
#pragma unroll
    for (int rr = 0; rr < 2; ++rr) {
      const int row = row0 + rr * stride;
      if (row < rows && row >= MLAT && nparts > 0) {
#pragma unroll
        for (int q = 0; q < 4; ++q) {
          for (int pp = 0; pp < nparts; ++pp) {
            const float4 t4 = *(const float4*)(PART + ((size_t)pp * 512 + (row - MLAT)) * D + q * 256 + lane * 4);
            x[rr][q].x += t4.x; x[rr][q].y += t4.y; x[rr][q].z += t4.z; x[rr][q].w += t4.w;
          }
          *(float4*)(S + (size_t)row * D + q * 256 + lane * 4) = x[rr][q];
        }
      }
#pragma unroll
      for (int q = 0; q < 4; ++q) ss[rr] += x[rr][q].x * x[rr][q].x + x[rr][q].y * x[rr][q].y + x[rr][q].z * x[rr][q].z + x[rr][q].w * x[rr][q].w;
    }
#pragma unroll
    for (int o = 1; o < 64; o <<= 1) { ss[0] += __shfl_xor(ss[0], o); ss[1] += __shfl_xor(ss[1], o); }
#pragma unroll
    for (int rr = 0; rr < 2; ++rr) {
      const int row = row0 + rr * stride;
      if (row < rows) {
        const int grp = (row < SEQ) ? 0 : ((row < MLAT) ? 1 : 2);
        const float* sh = MOD + grp * 9216 + (3 * k) * D;
        const float* sc = sh + D;
        const float rstd = rsqrtf(ss[rr] * (1.f / 1024.f) + EPSN);
#pragma unroll
        for (int q = 0; q < 4; ++q) {
          const int c = q * 256 + lane * 4;
          const float4 g = *(const float4*)(nw + c);
          const float4 s1 = *(const float4*)(sc + c);
          const float4 s0 = *(const float4*)(sh + c);
          uint2 pk;
          pk.x = pack2(x[rr][q].x * rstd * g.x * (1.f + s1.x) + s0.x, x[rr][q].y * rstd * g.y * (1.f + s1.y) + s0.y);
          pk.y = pack2(x[rr][q].z * rstd * g.z * (1.f + s1.z) + s0.z, x[rr][q].w * rstd * g.w * (1.f + s1.w) + s0.w);
          *(uint2*)(HB + (size_t)row * D + c) = pk;
        }
      }
    }
  }
}

__device__ __forceinline__ void attention_phase(const Params& p, int ai, char* lds) {
  const int G = gridDim.x, tid = tid_(), lane = tid & 63, w = tid >> 6;
  const int l31 = lane & 31, hh = lane >> 5;
  const bf16_t* Q = (const bf16_t*)(p.ws + OFF_Q);
  const bf16_t* KB = (const bf16_t*)(p.ws + OFF_KB);
  const bf16_t* VT = (const bf16_t*)(p.ws + OFF_VT);
  bf16_t* OB = (bf16_t*)(p.ws + OFF_OB);
  const int lrow = tid >> 3, lch = tid & 7;
  float sbound;
  {
    float mq = fabsf(p.in[11][ai * 64 + lane]), mk = fabsf(p.in[12][ai * 64 + lane]);
#pragma unroll
    for (int o = 1; o < 64; o <<= 1) { mq = fmaxf(mq, __shfl_xor(mq, o)); mk = fmaxf(mk, __shfl_xor(mk, o)); }
    sbound = fminf(8.f * mq * mk * 1.4426950408889634f, 100.f);
  }
  for (int it = blockIdx.x; it < 1024 + 32; it += G) {
    int b, head, rowbase, nT;
    if (it < 1024) { b = it >> 9; head = (it >> 5) & 15; rowbase = b * SEQ + (it & 31) * 256; nT = NKEY / 64; }
    else { const int r = it - 1024; b = r >> 4; head = r & 15; rowbase = MLAT + b * CTXL; nT = CTXL / 64; }
    const int kvh = head >> 2;
    const bf16_t* kp = KB + ((size_t)(b * 4 + kvh) * NKEY + lrow) * 64 + lch * 8;
    const bf16_t* vp = VT + ((size_t)(b * 4 + kvh) * 64 + lrow) * NKEY + lch * 8;
    bf16x8 qf[4];
    {
      const bf16_t* qp = Q + (size_t)(rowbase + w * 32 + l31) * D + head * 64 + hh * 8;
#pragma unroll
      for (int ks = 0; ks < 4; ++ks) qf[ks] = *(const bf16x8*)(qp + ks * 16);
    }
    f32x16 o0, o1;
#pragma unroll
    for (int i = 0; i < 16; ++i) { o0[i] = 0.f; o1[i] = 0.f; }
    f32x16 negm;
#pragma unroll
    for (int i = 0; i < 16; ++i) negm[i] = -sbound;
    float lsa = 0.f, lsb = 0.f;
    uint4 rk = *(const uint4*)(kp);
    uint4 rv = *(const uint4*)(vp);
    *(uint4*)(lds + swz(lrow, lch)) = rk;
    *(uint2*)(lds + 16384 + lrow * 136 + lch * 16) = make_uint2(rv.x, rv.y);
    *(uint2*)(lds + 16384 + lrow * 136 + lch * 16 + 8) = make_uint2(rv.z, rv.w);
    __syncthreads();
    for (int kt = 0; kt < nT; ++kt) {
      char* cK = lds + (kt & 1) * 8192;
      char* cV = lds + 16384 + (kt & 1) * 8704;
      const bool more = (kt + 1 < nT);
      if (more) {
        rk = *(const uint4*)(kp + (size_t)(kt + 1) * 64 * 64);
        rv = *(const uint4*)(vp + (kt + 1) * 64);
      }
      f32x16 s0, s1;
      {
        const bf16x8 a0 = *(const bf16x8*)(cK + swz(l31, hh));
        const bf16x8 a1 = *(const bf16x8*)(cK + swz(l31 + 32, hh));
        s0 = __builtin_amdgcn_mfma_f32_32x32x16_bf16(a0, qf[0], negm, 0, 0, 0);
        s1 = __builtin_amdgcn_mfma_f32_32x32x16_bf16(a1, qf[0], negm, 0, 0, 0);
      }
#pragma unroll
      for (int ks = 1; ks < 4; ++ks) {
        const bf16x8 a0 = *(const bf16x8*)(cK + swz(l31, 2 * ks + hh));
        const bf16x8 a1 = *(const bf16x8*)(cK + swz(l31 + 32, 2 * ks + hh));
        s0 = __builtin_amdgcn_mfma_f32_32x32x16_bf16(a0, qf[ks], s0, 0, 0, 0);
        s1 = __builtin_amdgcn_mfma_f32_32x32x16_bf16(a1, qf[ks], s1, 0, 0, 0);
      }
#pragma unroll
      for (int i = 0; i < 16; i += 2) {
        s0[i] = __builtin_amdgcn_exp2f(s0[i]); s0[i + 1] = __builtin_amdgcn_exp2f(s0[i + 1]);
        s1[i] = __builtin_amdgcn_exp2f(s1[i]); s1[i + 1] = __builtin_amdgcn_exp2f(s1[i + 1]);
        lsa += s0[i] + s1[i];
        lsb += s0[i + 1] + s1[i + 1];
      }
      bf16x8 pf[4];
#pragma unroll
      for (int j = 0; j < 4; ++j) {
        u32x4 cv;
#pragma unroll
        for (int q2 = 0; q2 < 4; ++q2) {
          const int i0 = 8 * (j & 1) + 2 * q2;
          const float x0 = (j < 2) ? s0[i0] : s1[i0];
          const float x1 = (j < 2) ? s0[i0 + 1] : s1[i0 + 1];
          cv[q2] = cvt_pk_bf16(x0, x1);
        }
        pf[j] = __builtin_bit_cast(bf16x8, cv);
      }
#pragma unroll
      for (int j = 0; j < 4; ++j) {
        const char* r0 = cV + l31 * 136 + j * 32 + hh * 8;
        const char* r1 = cV + (l31 + 32) * 136 + j * 32 + hh * 8;
        const uint2 x0 = *(const uint2*)(r0), x1 = *(const uint2*)(r0 + 16);
        const uint2 y0 = *(const uint2*)(r1), y1 = *(const uint2*)(r1 + 16);
        const u32x4 v0 = {x0.x, x0.y, x1.x, x1.y};
        const u32x4 v1 = {y0.x, y0.y, y1.x, y1.y};
        o0 = __builtin_amdgcn_mfma_f32_32x32x16_bf16(__builtin_bit_cast(bf16x8, v0), pf[j], o0, 0, 0, 0);
        o1 = __builtin_amdgcn_mfma_f32_32x32x16_bf16(__builtin_bit_cast(bf16x8, v1), pf[j], o1, 0, 0, 0);
      }
      if (more) {
        char* nK = lds + ((kt + 1) & 1) * 8192;
        char* nV = lds + 16384 + ((kt + 1) & 1) * 8704;
        *(uint4*)(nK + swz(lrow, lch)) = rk;
        *(uint2*)(nV + lrow * 136 + lch * 16) = make_uint2(rv.x, rv.y);
        *(uint2*)(nV + lrow * 136 + lch * 16 + 8) = make_uint2(rv.z, rv.w);
      }
      __syncthreads();
    }
    float lsum = lsa + lsb;
    lsum += __shfl_xor(lsum, 32);
    const float inv = 1.f / lsum;
    bf16_t* op = OB + (size_t)(rowbase + w * 32 + l31) * D + head * 64 + hh * 4;
#pragma unroll
    for (int g4 = 0; g4 < 4; ++g4) {
      uint2 pk;
      pk.x = pack2(o0[g4 * 4 + 0] * inv, o0[g4 * 4 + 1] * inv);
      pk.y = pack2(o0[g4 * 4 + 2] * inv, o0[g4 * 4 + 3] * inv);
      *(uint2*)(op + g4 * 8) = pk;
      pk.x = pack2(o1[g4 * 4 + 0] * inv, o1[g4 * 4 + 1] * inv);
      pk.y = pack2(o1[g4 * 4 + 2] * inv, o1[g4 * 4 + 3] * inv);
      *(uint2*)(op + 32 + g4 * 8) = pk;
    }
  }
}

__device__ __forceinline__ void dft16(float2 (&v)[16]) {
  float2 t[4][4];
#pragma unroll
  for (int a = 0; a < 4; ++a) {
    const float2 x0 = v[a], x1 = v[a + 4], x2 = v[a + 8], x3 = v[a + 12];
    const float2 s0 = make_float2(x0.x + x2.x, x0.y + x2.y), s1 = make_float2(x0.x - x2.x, x0.y - x2.y);
    const float2 s2 = make_float2(x1.x + x3.x, x1.y + x3.y), s3 = make_float2(x1.x - x3.x, x1.y - x3.y);
    t[a][0] = make_float2(s0.x + s2.x, s0.y + s2.y);
    t[a][1] = make_float2(s1.x + s3.y, s1.y - s3.x);
    t[a][2] = make_float2(s0.x - s2.x, s0.y - s2.y);
    t[a][3] = make_float2(s1.x - s3.y, s1.y + s3.x);
  }
  const float C1 = 0.92387953251128674f, S1 = 0.38268343236508977f, R2 = 0.70710678118654752f;
  t[1][1] = cmul(t[1][1], make_float2(C1, -S1));
  t[1][2] = cmul(t[1][2], make_float2(R2, -R2));
  t[1][3] = cmul(t[1][3], make_float2(S1, -C1));
  t[2][1] = cmul(t[2][1], make_float2(R2, -R2));
  t[2][2] = make_float2(t[2][2].y, -t[2][2].x);
  t[2][3] = cmul(t[2][3], make_float2(-R2, -R2));
  t[3][1] = cmul(t[3][1], make_float2(S1, -C1));
  t[3][2] = cmul(t[3][2], make_float2(-R2, -R2));
  t[3][3] = cmul(t[3][3], make_float2(-C1, S1));
#pragma unroll
  for (int c = 0; c < 4; ++c) {
    const float2 x0 = t[0][c], x1 = t[1][c], x2 = t[2][c], x3 = t[3][c];
    const float2 s0 = make_float2(x0.x + x2.x, x0.y + x2.y), s1 = make_float2(x0.x - x2.x, x0.y - x2.y);
    const float2 s2 = make_float2(x1.x + x3.x, x1.y + x3.y), s3 = make_float2(x1.x - x3.x, x1.y - x3.y);
    v[c] = make_float2(s0.x + s2.x, s0.y + s2.y);
    v[c + 4] = make_float2(s1.x + s3.y, s1.y - s3.x);
    v[c + 8] = make_float2(s0.x - s2.x, s0.y - s2.y);
    v[c + 12] = make_float2(s1.x - s3.y, s1.y + s3.x);
  }
}

__device__ __forceinline__ void r16_pass(float2 (&r)[16], float2* buf, int tid, int Ns) {
  const int k = tid & (Ns - 1);
  const float2 w1 = cexp_rev(-(float)k / (float)(16 * Ns));
  float2 w = w1;
#pragma unroll
  for (int i = 1; i < 16; ++i) {
    r[i] = cmul(r[i], w);
    w = cmul(w, w1);
  }
  dft16(r);
  const int j0 = ((tid - k) << 4) + k;
#pragma unroll
  for (int m = 0; m < 16; ++m) { const int ix = j0 + m * Ns; buf[ix + (ix >> 4)] = r[m]; }
}

__device__ __forceinline__ void fft8192(float2 (&r)[16], float2* buf, int tid) {
#pragma unroll 1
  for (int Ns = 1; Ns < 4096; Ns <<= 4) {
    r16_pass(r, buf, tid, Ns);
    __syncthreads();
#pragma unroll
    for (int i = 0; i < 16; ++i) { const int ix = tid + 512 * i; r[i] = buf[ix + (ix >> 4)]; }
    __syncthreads();
  }
#pragma unroll
  for (int b = 0; b < 8; ++b) {
    const int j = tid + 512 * b;
    const float2 a0 = r[b];
    const float2 a1 = cmul(r[b + 8], cexp_rev(-(float)j * (1.f / 8192.f)));
    r[b] = make_float2(a0.x + a1.x, a0.y + a1.y);
    r[b + 8] = make_float2(a0.x - a1.x, a0.y - a1.y);
  }
}

__device__ __forceinline__ void stage_rows(const bf16_t* r0, const bf16_t* r1, char* dst, int tid) {
#pragma unroll
  for (int i = 0; i < 4; ++i) {
    const int c = tid + 512 * i;
    const bf16_t* src = (c < 1024) ? (r0 + c * 8) : (r1 + (c - 1024) * 8);
    *(uint4*)(dst + c * 16) = *(const uint4*)src;
  }
}

__device__ __forceinline__ void hyena_conv_phase(const Params& p, int j, bool with_ctx, char* lds) {
  const int G = gridDim.x, tid = tid_();
  const bf16_t* U = (const bf16_t*)(p.ws + OFF_ACT);
  const bf16_t* FILT = (const bf16_t*)(p.ws + OFF_FILT);
  bf16_t* YT = (bf16_t*)(p.ws + OFF_YT);
  const float* cw = p.in[15] + (size_t)j * 3 * 3072;
  const float* cb = p.in[16] + (size_t)j * 3072;
  const float* fbias = p.in[25] + (size_t)j * 2 * D;
  float2* buf0 = (float2*)lds;
  float2* bufH = buf0 + 8704;
  const int nitems = with_ctx ? 2048 : 1024;
  for (int it = blockIdx.x; it < nitems; it += G) {
    if (it < 1024) {
      const int d = it;
      float2 acc[16], r[16], xr[16];
      unsigned* zE = (unsigned*)bufH;
      unsigned* zO = zE + 8192;
#pragma unroll 1
      for (int part = 0; part < 2; ++part) {
        int tq = threadIdx.x;
        asm volatile("" : "+v"(tq));
        stage_rows(FILT + (size_t)(0 * 1024 + d) * SEQ, FILT + (size_t)(1 * 1024 + d) * SEQ, lds, tq);
        stage_rows(FILT + (size_t)(2 * 1024 + d) * SEQ, FILT + (size_t)(3 * 1024 + d) * SEQ, lds + 32768, tq);
        __syncthreads();
        const bf16_t* st = (const bf16_t*)lds;
#pragma unroll
        for (int i = 0; i < 16; ++i) {
          const int n = tq + 512 * i;
          const int nb = (n == 0) ? 0 : (SEQ - n);
          const float f0 = bf2f(st[n]), g0 = bf2f(st[SEQ + nb]);
          const float f1 = bf2f(st[2 * SEQ + n]), g1 = bf2f(st[3 * SEQ + nb]);
          if (part == 0) r[i] = make_float2(f0 + g0, f1 + g1);
          else {
            const float d0 = (n == 0) ? (f0 + g0) : (f0 - g0);
            const float d1 = (n == 0) ? (f1 + g1) : (f1 - g1);
            r[i] = cmul(make_float2(d0, d1), cexp_rev(-(float)n * (1.f / 16384.f)));
          }
        }
        __syncthreads();
        fft8192(r, buf0, tq);
        unsigned* zz = part ? zO : zE;
#pragma unroll
        for (int i = 0; i < 16; ++i) zz[tq + 512 * i] = pack2(r[i].x, r[i].y);
      }
      __syncthreads();
      {
        int t0 = threadIdx.x;
        asm volatile("" : "+v"(t0));
        const bf16_t* u0 = U + (size_t)d * MALL;
        stage_rows(u0, u0 + SEQ, lds, t0);
        __syncthreads();
        const bf16_t* st = (const bf16_t*)lds;
        const float w0 = cw[d], w1 = cw[3072 + d], w2 = cw[6144 + d], bb = cb[d];
#pragma unroll
        for (int i = 0; i < 16; ++i) {
          const int n = t0 + 512 * i;
          float vv[2];
#pragma unroll
          for (int b = 0; b < 2; ++b) {
            const bf16_t* ub = st + b * SEQ + n;
            const float um0 = bf2f(ub[(n > 0) ? -1 : 0]);
            const float uc = bf2f(ub[0]);
            const float up0 = bf2f(ub[(n < SEQ - 1) ? 1 : 0]);
            const float um = (n > 0) ? um0 : 0.f;
            const float up = (n < SEQ - 1) ? up0 : 0.f;
            vv[b] = um * w0 + uc * w1 + up * w2 + bb;
          }
          xr[i] = make_float2(vv[0], vv[1]);
        }
        __syncthreads();
      }
#pragma unroll 1
      for (int o = 0; o < 2; ++o) {
#pragma unroll 1
        for (int step = 1; step < 6; ++step) {
          if (step == 3) continue;
          int tq = threadIdx.x;
          asm volatile("" : "+v"(tq));
          if (step == 1) {
#pragma unroll
            for (int i = 0; i < 16; ++i) r[i] = xr[i];
          } else if (step == 4) {
#pragma unroll
            for (int i = 0; i < 16; ++i) {
              const int n = tq + 512 * i;
              r[i] = cmul(xr[i], cexp_rev(-(float)n * (1.f / 16384.f)));
            }
          }
          fft8192(r, buf0, tq);
          if (step == 1 || step == 4) {
            const unsigned* zz = (step == 1) ? zE : zO;
#pragma unroll
            for (int i = 0; i < 16; ++i) {
              const int k = tq + 512 * i;
              const int km = (step == 1) ? ((SEQ - k) & (SEQ - 1)) : (SEQ - 1 - k);
              const unsigned za = zz[k], zb = zz[km];
              const float2 Z = make_float2(__uint_as_float(za << 16), __uint_as_float(za & 0xffff0000u));
              const float2 Zm = make_float2(__uint_as_float(zb << 16), -__uint_as_float(zb & 0xffff0000u));
              float2 H;
              if (o == 0) H = make_float2(0.5f * (Z.x + Zm.x), 0.5f * (Z.y + Zm.y));
              else H = make_float2(0.5f * (Z.y - Zm.y), -0.5f * (Z.x - Zm.x));
              const float2 y = cmul(r[i], H);
              r[i] = make_float2(y.x, -y.y);
            }
          } else if (step == 2) {
#pragma unroll
            for (int i = 0; i < 16; ++i) acc[i] = make_float2(r[i].x, -r[i].y);
          } else {
#pragma unroll
            for (int i = 0; i < 16; ++i) {
              const int n = tq + 512 * i;
              const float2 wc = cexp_rev((float)n * (1.f / 16384.f));
              const float2 io = make_float2(r[i].x, -r[i].y);
              const float2 y = cmul(wc, io);
              acc[i] = make_float2((acc[i].x + y.x) * (1.f / 16384.f), (acc[i].y + y.y) * (1.f / 16384.f));
            }
          }
        }
        const int gc = (o == 0) ? (1024 + d) : (2048 + d);
        const bf16_t* ug = U + (size_t)gc * MALL;
        const float w0 = cw[gc], w1 = cw[3072 + gc], w2 = cw[6144 + gc], bb = cb[gc];
        const float fb = fbias[o * D + d];
        int te = threadIdx.x;
        asm volatile("" : "+v"(te));
        stage_rows(ug, ug + SEQ, lds, te);
        __syncthreads();
        const bf16_t* stg = (const bf16_t*)lds;
#pragma unroll
        for (int i = 0; i < 16; ++i) {
          const int n = te + 512 * i;
          float gg[2];
#pragma unroll
          for (int b = 0; b < 2; ++b) {
            const bf16_t* ub = stg + b * SEQ + n;
            const float um0 = bf2f(ub[(n > 0) ? -1 : 0]);
            const float uc = bf2f(ub[0]);
            const float up0 = bf2f(ub[(n < SEQ - 1) ? 1 : 0]);
            const float um = (n > 0) ? um0 : 0.f;
            const float up = (n < SEQ - 1) ? up0 : 0.f;
            gg[b] = um * w0 + uc * w1 + up * w2 + bb;
          }
          const float2 xv = xr[i];
          const float z0 = gg[0] * (acc[i].x + xv.x * fb);
          const float z1 = gg[1] * (acc[i].y + xv.y * fb);
          if (o == 0) xr[i] = make_float2(z0, z1);
          else {
            YT[(size_t)d * MALL + n] = f2bf(z0);
            YT[(size_t)d * MALL + SEQ + n] = f2bf(z1);
          }
        }
        __syncthreads();
      }
    } else {
      const int d = it - 1024;
      const int tc = tid_();
      float* Fc = (float*)lds;
      float* zs = Fc + 1024;
      const float* hid = (const float*)(p.ws + OFF_HID3C) + (size_t)j * 256 * 64;
      const float* wout = p.in[23] + (size_t)j * 64 * 4096;
      const float delta = fabsf(-3.0701134573253945f + (float)d * ((-15.350567286626973f + 3.0701134573253945f) / 1023.f));
#pragma unroll
      for (int i = 0; i < 2; ++i) {
        const int idx = tc + 512 * i;
        const int od = idx >> 8, t = idx & 255;
        float s = 0.f;
        for (int h = 0; h < 64; ++h) s += hid[t * 64 + h] * wout[(size_t)h * 4096 + od * 1024 + d];
        Fc[idx] = s * __expf(-(float)t * (1.f / 255.f) * delta);
      }
      const int b = tc >> 8, t = tc & 255;
      float sc3[3];
#pragma unroll
      for (int c3 = 0; c3 < 3; ++c3) {
        const int col = c3 * 1024 + d;
        const bf16_t* ub = U + (size_t)col * MALL + MLAT + b * CTXL + t;
        const float um0 = bf2f(ub[(t > 0) ? -1 : 0]);
        const float uc = bf2f(ub[0]);
        const float up0 = bf2f(ub[(t < CTXL - 1) ? 1 : 0]);
        const float um = (t > 0) ? um0 : 0.f;
        const float up = (t < CTXL - 1) ? up0 : 0.f;
        sc3[c3] = um * cw[col] + uc * cw[3072 + col] + up * cw[6144 + col] + cb[col];
      }
      float zin = sc3[0];
#pragma unroll 1
      for (int o = 0; o < 2; ++o) {
        __syncthreads();
        zs[b * 256 + t] = zin;
        __syncthreads();
        const float* fwd = Fc + (o * 2) * 256;
        const float* bwd = fwd + 256;
        float a = 0.f;
        for (int s = 0; s < 256; ++s) {
          const int dd = t - s;
          const float tap = (dd > 0) ? fwd[dd] : ((dd < 0) ? bwd[-dd] : (fwd[0] + bwd[0]));
          a += tap * zs[b * 256 + s];
        }
        const float res = sc3[1 + o] * (a + zin * fbias[o * D + d]);
        if (o == 0) zin = res;
        else YT[(size_t)d * MALL + MLAT + b * CTXL + t] = f2bf(res);
      }
      __syncthreads();
    }
  }
}

__device__ __forceinline__ void transpose_y_phase(const Params& p, int ntok, char* lds) {
  const int G = gridDim.x, tid = tid_();
  const bf16_t* YT = (const bf16_t*)(p.ws + OFF_YT);
  bf16_t* YB = (bf16_t*)(p.ws + OFF_OB);
  unsigned* T = (unsigned*)lds;
  const int ntt = ntok >> 7;
  const int lane = tid & 63, w = tid >> 6;
  const int ch = lane >> 2, dp = (lane & 3) + 4 * w;
  for (int t = blockIdx.x; t < 16 * ntt; t += G) {
    const int dt = t / ntt, tt = t - dt * ntt;
    {
      const bf16_t* g = YT + (size_t)(dt * 64 + 2 * dp) * MALL + tt * 128 + ch * 8;
      const uint4 a = *(const uint4*)(g);
      const uint4 c = *(const uint4*)(g + MALL);
      unsigned* tp = T + (ch * 8) * 33 + dp;
      tp[0 * 33] = (a.x & 0xffffu) | (c.x << 16);  tp[1 * 33] = (a.x >> 16) | (c.x & 0xffff0000u);
      tp[2 * 33] = (a.y & 0xffffu) | (c.y << 16);  tp[3 * 33] = (a.y >> 16) | (c.y & 0xffff0000u);
      tp[4 * 33] = (a.z & 0xffffu) | (c.z << 16);  tp[5 * 33] = (a.z >> 16) | (c.z & 0xffff0000u);
      tp[6 * 33] = (a.w & 0xffffu) | (c.w << 16);  tp[7 * 33] = (a.w >> 16) | (c.w & 0xffff0000u);
    }
    __syncthreads();
#pragma unroll
    for (int i = 0; i < 2; ++i) {
      const int idx = tid + 512 * i;
      const int tk = idx >> 3, q = idx & 7;
      const unsigned* tp = T + tk * 33 + q * 4;
      uint4 o;
      o.x = tp[0]; o.y = tp[1]; o.z = tp[2]; o.w = tp[3];
      *(uint4*)(YB + (size_t)(tt * 128 + tk) * D + dt * 64 + q * 8) = o;
    }
    __syncthreads();
  }
}

#define XB_TMO      128
#define XB_XCNT(j)  (256  + 64 * (j))
#define XB_XSUB(j)  (1280 + 64 * (j))
#define XB_XGEN(j)  (2304 + 64 * (j))
#define XB_TOP      3328
#define XB_TOPGEN   3392
#define XCD_BAR_WORDS 3456
#define XB_SPIN_CAP (1u << 18)
#define LAS __attribute__((address_space(3)))

__device__ __forceinline__ unsigned xb_ld(unsigned* p)              { return __hip_atomic_load(p, __ATOMIC_RELAXED, __HIP_MEMORY_SCOPE_AGENT); }
__device__ __forceinline__ unsigned xb_add(unsigned* p, unsigned v) { return __hip_atomic_fetch_add(p, v, __ATOMIC_RELAXED, __HIP_MEMORY_SCOPE_AGENT); }
__device__ __forceinline__ unsigned xb_xcc_id() { return (unsigned)__builtin_amdgcn_s_getreg((3 << 11) | 20) & 0xFu; }
#define XB_SPIN(cond, bar) do { unsigned _sp = 0; while (cond) { __builtin_amdgcn_s_sleep(1); \
    if ((++_sp & 255u) == 0u) { if (xb_ld(&(bar)[XB_TMO])) break; if (_sp > XB_SPIN_CAP) { atomicAdd(&(bar)[XB_TMO], 1u); break; } } } } while (0)

struct XcdBarrier {
    unsigned* bar; unsigned x;
    volatile LAS unsigned* st;
};

__device__ __forceinline__ XcdBarrier xcd_barrier_post(unsigned* bar, volatile LAS unsigned* st) {
    XcdBarrier b; b.bar = bar; b.x = xb_xcc_id(); b.st = st;
    if (threadIdx.x == 0) (void)xb_add(&bar[XB_XCNT(b.x)], 1u);
    return b;
}
__device__ __forceinline__ void xcd_barrier_complete(unsigned* bar, unsigned x, unsigned& nloc, unsigned& nx) {
    const unsigned G = gridDim.x * gridDim.y * gridDim.z;
    unsigned sum, cnt, mine, sp = 0u;
    for (;;) {
        sum = 0u; cnt = 0u; mine = 0u;
#pragma unroll
        for (unsigned j = 0; j < 16; ++j) { const unsigned c = xb_ld(&bar[XB_XCNT(j)]); sum += c; cnt += (c > 0u) ? 1u : 0u; mine = (j == x) ? c : mine; }
        if (sum == G) break;
        __builtin_amdgcn_s_sleep(1);
        if ((++sp & 255u) == 0u) { if (xb_ld(&bar[XB_TMO])) break; if (sp > XB_SPIN_CAP) { atomicAdd(&bar[XB_TMO], 1u); break; } }
    }
    nloc = mine > 0u ? mine : 1u; nx = cnt > 0u ? cnt : 1u;
}

__device__ __forceinline__ void xcd_barrier(const XcdBarrier& b) {
    asm volatile("s_waitcnt vmcnt(0)" ::: "memory");
    __syncthreads();
    if (threadIdx.x == 0) {
        unsigned* bar = b.bar;
        __builtin_amdgcn_s_waitcnt(0);
        unsigned nloc = b.st[0], nx = b.st[1];
        if (nloc == 0u) { xcd_barrier_complete(bar, b.x, nloc, nx); b.st[0] = nloc; b.st[1] = nx; }
        const unsigned old = xb_add(&bar[XB_XSUB(b.x)], 1u);
        const unsigned gen = old / nloc;
        if (old + 1u == (gen + 1u) * nloc) {
            __builtin_amdgcn_fence(__ATOMIC_RELEASE, "agent");
            asm volatile("s_waitcnt vmcnt(0)" ::: "memory");
            const unsigned og = xb_add(&bar[XB_TOP], 1u);
            const unsigned tg = og / nx;
            if (og + 1u == (tg + 1u) * nx) xb_add(&bar[XB_TOPGEN], 1u);
            else XB_SPIN(xb_ld(&bar[XB_TOPGEN]) == tg, bar);
            __builtin_amdgcn_fence(__ATOMIC_ACQUIRE, "agent");
            xb_add(&bar[XB_XGEN(b.x)], 1u);
            asm volatile("s_waitcnt vmcnt(0)" ::: "memory");
        } else {
            XB_SPIN(xb_ld(&bar[XB_XGEN(b.x)]) == gen, bar);
            __builtin_amdgcn_fence(__ATOMIC_ACQUIRE, "agent");
            asm volatile("s_waitcnt vmcnt(0)" ::: "memory");
        }
    }
    __syncthreads();
}


__device__ __forceinline__ void grid_barrier(unsigned* ctr, unsigned target) {
  asm volatile("s_waitcnt vmcnt(0)" ::: "memory");
  __syncthreads();
  if (threadIdx.x == 0) {
    __builtin_amdgcn_fence(__ATOMIC_RELEASE, "agent");
    asm volatile("s_waitcnt vmcnt(0)" ::: "memory");
    __hip_atomic_fetch_add(ctr, 1u, __ATOMIC_RELAXED, __HIP_MEMORY_SCOPE_AGENT);
    while (__hip_atomic_load(ctr, __ATOMIC_RELAXED, __HIP_MEMORY_SCOPE_AGENT) < target) __builtin_amdgcn_s_sleep(1);
    __builtin_amdgcn_fence(__ATOMIC_ACQUIRE, "agent");
  }
  __syncthreads();
}

__global__ void __launch_bounds__(NTHR, 2) fwd_megakernel(Params p) {
  extern __shared__ __attribute__((aligned(16))) char lds[];
  cg::grid_group grid = cg::this_grid();
  {
    volatile LAS unsigned* xst = (volatile LAS unsigned*)(lds + 139248);
    if (threadIdx.x < 4) xst[threadIdx.x] = 0u;
    __syncthreads();
  }
  if (blockIdx.x == 0) {
    unsigned* bw = (unsigned*)(p.ws + OFF_BAR);
    for (int i = threadIdx.x; i < 4096; i += NTHR) bw[i] = 0u;
  }
  XcdBarrier xbar;
  xbar.bar = (unsigned*)(p.ws + OFF_BAR); xbar.x = xb_xcc_id(); xbar.st = (volatile LAS unsigned*)(lds + 139248);
  char* ws = p.ws;
  unsigned nbar = 0;
  for (int ph = p.ph_lo; ph < p.ph_hi; ++ph) {
    int ptype = 8;
    if (ph > 0) {
      const int sub_ = (ph - 1) % 10, l_ = (ph - 1) / 10;
      ptype = (sub_ == 0 || sub_ == 3 || sub_ == 7) ? 0 : (sub_ == 1 || sub_ == 8) ? 1 : (sub_ == 2 || sub_ == 9) ? 2 : (sub_ == 6) ? 5 : (sub_ == 4) ? ((l_ & 1) ? 6 : 3) : ((l_ & 1) ? 7 : 4);
    }
    const int nrep = ((PROBE_MASK >> ptype) & 1) ? 2 : 1;
    for (int rep = 0; rep < nrep; ++rep) {
    if (rep > 0) { xcd_barrier(xbar); }
    if (ph == 0) {
      p0_prologue(p, lds);
    } else {
      const int l = (ph - 1) / 10, sub = (ph - 1) % 10;
      const bool is_attn = (l & 1) == 0;
      const int mi2 = l >> 1;
      const int rows = (l < 3) ? MALL : MLAT;
      const int MT = rows / 256;
      const float* MODL = (const float*)(ws + OFF_MOD) + (size_t)l * 3 * 9216;
      Epi e{};
      e.S = (float*)(ws + OFF_S);
      e.Sin = (l == 0 && sub == 2) ? p.in[0] : (const float*)(ws + OFF_S);
      if (sub == 0 || sub == 3 || sub == 7) {
        const int nparts = (sub == 0) ? ((l > 0) ? 11 : 0) : ((l < 3) ? ((sub == 3) ? 11 : 4) : 0);
        normmod_phase(p, l, sub == 0 ? 0 : (sub == 3 ? 1 : 2), rows, nparts);
      } else if (sub == 1 || sub == 8) {
        const int fi = l * 2 + (sub == 8);
        e.ob = (bf16_t*)(ws + OFF_ACT);
        gemm256_phase<EPI_SWIGLU>((const bf16_t*)(ws + OFF_HB), (const bf16_t*)(ws + OFF_WGU) + (size_t)fi * NGU * D, D, D / 64, MT, NGU / 256, lds, e, 0);
      } else if (sub == 2 || sub == 9 || sub == 6) {
        const bf16_t* A; const bf16_t* Bt; int K;
        e.out2 = nullptr; e.bias = nullptr;
        if (sub == 6) {
          if (!is_attn) {
            transpose_y_phase(p, rows, lds);
            xcd_barrier(xbar);
          }
          e.gate = MODL + 5 * D; e.coef = 1.f; K = D;
          A = (const bf16_t*)(ws + OFF_OB);
          if (is_attn) Bt = (const bf16_t*)(ws + OFF_WO) + (size_t)mi2 * D * D;
          else { Bt = (const bf16_t*)(ws + OFF_WHO) + (size_t)mi2 * D * D; e.bias = p.in[27] + (size_t)mi2 * D; }
        } else {
          const int fi = l * 2 + (sub == 9);
          e.gate = MODL + (sub == 2 ? 2 : 8) * D; e.coef = 0.5f; K = FF;
          A = (const bf16_t*)(ws + OFF_ACT);
          Bt = (const bf16_t*)(ws + OFF_WD) + (size_t)fi * D * FF;
          if (l == 3 && sub == 9) e.out2 = p.out;
        }
        if (rep + 1 < nrep) { e.coef = 0.f; e.out2 = nullptr; }
        const int nkt = K / 64;
        const int nlat = 256;
        const int nsplit = (l < 3) ? (nkt / 4) : 0;
        const int total = nlat + 8 * nsplit;
        const int G = gridDim.x;
        int bid = blockIdx.x;
        if ((G & 7) == 0) bid = (bid & 7) * (G >> 3) + (bid >> 3);
        for (int u = bid; u < total; u += G) {
          if (u < nlat) {
            e.atomic = 0;
            const int band = u >> 5, rem = u & 31;
            gemm256_tile<EPI_RESID>(A, Bt, K, 0, nkt, (band * 8 + (rem & 7)) * 256, (rem >> 3) * 256, lds, e, 0);
          } else {
            e.atomic = 1;
            e.part = (float*)(ws + OFF_PART);
            const int it = u - nlat;
            const int part = it >> 3, un = it & 7;
            gemm256_tile<EPI_RESID>(A, Bt, K, part * 4, 4, (64 + (un & 1)) * 256, (un >> 1) * 256, lds, e, part);
          }
        }
      } else if (sub == 4) {
        if (is_attn) {
          e.q = (bf16_t*)(ws + OFF_Q); e.kb = (bf16_t*)(ws + OFF_KB);
          e.qn = p.in[11] + mi2 * 64; e.kn = p.in[12] + mi2 * 64;
          const bf16_t* W = (const bf16_t*)(ws + OFF_WQKV) + (size_t)mi2 * 1536 * D;
          gemm256_phase<EPI_QK>((const bf16_t*)(ws + OFF_HB), W, D, D / 64, MT, 5, lds, e, 0);
          Epi e2{};
          e2.ob = (bf16_t*)(ws + OFF_VT); e2.ldo = NKEY; e2.vmode = 1; e2.bias = nullptr;
          gemm256_phase<EPI_T>(W + (size_t)1280 * D, (const bf16_t*)(ws + OFF_HB), D, D / 64, 1, MT, lds, e2, MT * 5);
        } else {
          Epi e2{};
          e2.ob = (bf16_t*)(ws + OFF_ACT); e2.ldo = MALL; e2.vmode = 0;
          e2.bias = p.in[14] + (size_t)mi2 * 3072;
          gemm256_phase<EPI_T>((const bf16_t*)(ws + OFF_WIN) + (size_t)mi2 * 3072 * D, (const bf16_t*)(ws + OFF_HB), D, D / 64, 12, MT, lds, e2, 0);
          Epi e3{};
          e3.ob = (bf16_t*)(ws + OFF_FILT);
          gemm256_phase<EPI_FILT>((const bf16_t*)(ws + OFF_WOUTT) + (size_t)mi2 * 4096 * 64, (const bf16_t*)(ws + OFF_HID3) + (size_t)mi2 * 8192 * 64, 64, 1, 16, 32, lds, e3, MT * 12);
        }
      } else if (sub == 5) {
        if (is_attn) attention_phase(p, mi2, lds);
        else hyena_conv_phase(p, mi2, l < 3, lds);
      }
    }
    }
    if (ph + 1 < p.ph_hi) {
      if (ph == 0) {
        grid.sync();
        if (threadIdx.x == 0) (void)xb_add(&xbar.bar[XB_XCNT(xbar.x)], 1u);
      }
      else { xcd_barrier(xbar); }
    }
  }
}

constexpr int LDS_BYTES = 139264;
constexpr int NPHASES = 41;

extern "C" void kernel_launch(void* const* d_in, const int* in_sizes, int n_in, void* d_out, int out_size,
                              void* d_ws, size_t ws_size, hipStream_t stream) {
  static int grid_blocks = 0;
  if (grid_blocks == 0) {
    if (ws_size < WS_END) { fprintf(stderr, "kernel_launch: workspace too small: %zu < %zu\n", ws_size, (size_t)WS_END); grid_blocks = -1; return; }
    int dev = 0, cus = 0, per_cu = 0;
    hipGetDevice(&dev);
    hipDeviceGetAttribute(&cus, hipDeviceAttributeMultiprocessorCount, dev);
    if (hipFuncSetAttribute((const void*)fwd_megakernel, hipFuncAttributeMaxDynamicSharedMemorySize, LDS_BYTES) != hipSuccess) {
      fprintf(stderr, "kernel_launch: hipFuncSetAttribute failed\n"); grid_blocks = -1; return;
    }
    hipOccupancyMaxActiveBlocksPerMultiprocessor(&per_cu, (const void*)fwd_megakernel, NTHR, LDS_BYTES);
    if (per_cu < 1) { fprintf(stderr, "kernel_launch: occupancy query says %d blocks/CU\n", per_cu); per_cu = 1; }
    grid_blocks = cus * 1;
    (void)hipGetLastError();
  }
  if (grid_blocks < 0) return;
  Params p{};
  for (int i = 0; i < 28; ++i) p.in[i] = (const float*)d_in[i];
  p.out = (float*)d_out;
  p.ws = (char*)d_ws;
  p.ph_lo = 0;
  p.ph_hi = NPHASES;
  void* args[] = {&p};
  hipError_t e = hipLaunchCooperativeKernel((const void*)fwd_megakernel, dim3(grid_blocks), dim3(NTHR), args, LDS_BYTES, stream);
  if (e != hipSuccess) fprintf(stderr, "cooperative launch failed: %s (grid %d)\n", hipGetErrorString(e), grid_blocks);
}
```

```cpp
#include <hip/hip_runtime.h>
#include <hip/hip_cooperative_groups.h>
#include <cstdio>
#include <cstdint>
namespace cg = cooperative_groups;

typedef unsigned short bf16_t;
typedef __attribute__((ext_vector_type(8))) short bf16x8;
typedef __attribute__((ext_vector_type(4))) float f32x4;
typedef __attribute__((ext_vector_type(16))) float f32x16;
typedef __attribute__((ext_vector_type(4))) unsigned u32x4;
typedef __attribute__((ext_vector_type(2))) float f32x2;

#define NTHR 512
#ifndef PROBE_MASK
#define PROBE_MASK 0
#endif
constexpr int D = 1024, FF = 2816, NGU = 5632, SEQ = 8192, CTXL = 256, MLAT = 16384, MALL = 16896, NKEY = 8448;
constexpr float EPSN = 1e-6f;

constexpr size_t OFF_BAR = 0;
constexpr size_t OFF_MOD = 16384;
constexpr size_t OFF_HID3 = OFF_MOD + 442368;
constexpr size_t OFF_HID3C = OFF_HID3 + 2097152;
constexpr size_t OFF_WOUTT = OFF_HID3C + 131072;
constexpr size_t OFF_WGU = OFF_WOUTT + 1048576;
constexpr size_t OFF_WD = OFF_WGU + 92274688;
constexpr size_t OFF_WQKV = OFF_WD + 46137344;
constexpr size_t OFF_WO = OFF_WQKV + 6291456;
constexpr size_t OFF_WIN = OFF_WO + 4194304;
constexpr size_t OFF_WHO = OFF_WIN + 12582912;
constexpr size_t OFF_S = OFF_WHO + 4194304;
constexpr size_t OFF_HB = OFF_S + 69206016;
constexpr size_t OFF_ACT = OFF_HB + 34603008;
constexpr size_t OFF_Q = OFF_ACT + 95158272;
constexpr size_t OFF_KB = OFF_Q + 34603008;
constexpr size_t OFF_VT = OFF_KB + 8650752;
constexpr size_t OFF_OB = OFF_VT + 8650752;
constexpr size_t OFF_FILT = OFF_OB + 34603008;
constexpr size_t OFF_XS = OFF_FILT + 67108864;
constexpr size_t OFF_PART = OFF_XS + (size_t)512 * 65536;
constexpr size_t OFF_YT = OFF_PART + (size_t)11 * 512 * 1024 * 4;
constexpr size_t WS_END = OFF_YT + (size_t)1024 * 16896 * 2;

struct Params {
  const float* in[28];
  float* out;
  char* ws;
  int ph_lo, ph_hi;
};

__device__ __forceinline__ int tid_() { int t = threadIdx.x; asm volatile("" : "+v"(t)); return t; }
__device__ __forceinline__ bf16_t f2bf(float f) {
  unsigned u = __float_as_uint(f);
  u += 0x7fffu + ((u >> 16) & 1u);
  return (bf16_t)(u >> 16);
}
__device__ __forceinline__ float bf2f(bf16_t h) { return __uint_as_float(((unsigned)h) << 16); }

__device__ __forceinline__ unsigned cvt_pk_bf16(float lo, float hi) { unsigned r; asm volatile("v_cvt_pk_bf16_f32 %0, %1, %2" : "=v"(r) : "v"(lo), "v"(hi)); return r; }
__device__ __forceinline__ unsigned pack2(float a, float b) { return cvt_pk_bf16(a, b); }
__device__ __forceinline__ float silu_f(float x) { return x * __builtin_amdgcn_rcpf(1.f + __expf(-x)); }
__device__ __forceinline__ int swz(int row, int ch) { return row * 128 + ((ch ^ ((row >> 1) & 7)) << 4); }
__device__ __forceinline__ float2 cmul(float2 a, float2 b) { return make_float2(a.x * b.x - a.y * b.y, a.x * b.y + a.y * b.x); }
__device__ __forceinline__ float2 cexp_rev(float rev) { return make_float2(__builtin_amdgcn_cosf(rev), __builtin_amdgcn_sinf(rev)); }

enum { EPI_SWIGLU = 0, EPI_RESID = 1, EPI_QK = 2, EPI_T = 3, EPI_FILT = 4 };

struct Epi {
  float* S; const float* Sin; float* out2; const float* gate; const float* bias; float coef;
  bf16_t* ob; int ldo; int vmode; int atomic; float* part;
  bf16_t* q; bf16_t* kb; const float* qn; const float* kn;
};

__device__ __forceinline__ int swz32(int row, int ch) { return row * 64 + ((ch ^ ((0 - (row >> 2)) & 3)) << 4); }

template <int EPI>
__device__ __forceinline__ void gemm256_tile(const bf16_t* A, const bf16_t* Bt, int ld, int kt0, int nkt, int m0, int n0, char* lds, const Epi& e, int part) {
  const int tid = tid_(), lane = tid & 63, w = __builtin_amdgcn_readfirstlane(tid >> 6);
  const int wm = w >> 2, wn = w & 3;
  const int fr = lane & 15, fq = lane >> 4;
  f32x4 acc[8][4];
#pragma unroll
  for (int i = 0; i < 8; ++i)
#pragma unroll
    for (int j = 0; j < 4; ++j) acc[i][j] = (f32x4){0.f, 0.f, 0.f, 0.f};
  unsigned soff[2];
#pragma unroll
  for (int i = 0; i < 2; ++i) {
    const int r = 16 * (w * 2 + i) + (lane >> 2);
    const int c = (lane & 3) ^ ((0 - (r >> 2)) & 3);
    soff[i] = (unsigned)(r * ld + c * 8);
  }
  const int nks = nkt * 2;
  const bf16_t* Ab = A + (size_t)m0 * ld + (size_t)kt0 * 64;
  const bf16_t* Bb = Bt + (size_t)n0 * ld + (size_t)kt0 * 64;
  char* ldsw = lds + w * 2048;
#define G256_ISSUE(step)                                                                                                        \
  do {                                                                                                                          \
    const int st_ = (step) < nks ? (step) : (nks - 1);                                                                          \
    char* dA_ = ldsw + ((step) & 3) * 32768;                                                                                    \
    const bf16_t* ga_ = Ab + (size_t)st_ * 32;                                                                                  \
    const bf16_t* gb_ = Bb + (size_t)st_ * 32;                                                                                  \
    __builtin_amdgcn_global_load_lds((const unsigned*)(ga_ + soff[0]), (unsigned*)(dA_), 16, 0, 0);                             \
    __builtin_amdgcn_global_load_lds((const unsigned*)(ga_ + soff[1]), (unsigned*)(dA_ + 1024), 16, 0, 0);                      \
    __builtin_amdgcn_global_load_lds((const unsigned*)(gb_ + soff[0]), (unsigned*)(dA_ + 16384), 16, 0, 0);                     \
    __builtin_amdgcn_global_load_lds((const unsigned*)(gb_ + soff[1]), (unsigned*)(dA_ + 16384 + 1024), 16, 0, 0);              \
  } while (0)
  G256_ISSUE(0);
  G256_ISSUE(1);
  G256_ISSUE(2);
  for (int t = 0; t < nks; ++t) {
    asm volatile("s_waitcnt vmcnt(8) lgkmcnt(0)" ::: "memory");
    __builtin_amdgcn_s_barrier();
    asm volatile("" ::: "memory");
    G256_ISSUE(t + 3);
    const char* cA = lds + (t & 3) * 32768;
    const char* cB = cA + 16384;
    bf16x8 bfr[4];
#pragma unroll
    for (int ni = 0; ni < 4; ++ni) bfr[ni] = *(const bf16x8*)(cB + swz32(wn * 64 + ni * 16 + fr, fq));
#pragma unroll
    for (int mh = 0; mh < 2; ++mh) {
      bf16x8 af[4];
#pragma unroll
      for (int mi = 0; mi < 4; ++mi) af[mi] = *(const bf16x8*)(cA + swz32(wm * 128 + (mh * 4 + mi) * 16 + fr, fq));
#pragma unroll
      for (int mi = 0; mi < 4; ++mi)
#pragma unroll
        for (int ni = 0; ni < 4; ++ni)
          acc[mh * 4 + mi][ni] = __builtin_amdgcn_mfma_f32_16x16x32_bf16(bfr[ni], af[mi], acc[mh * 4 + mi][ni], 0, 0, 0);
    }
  }
  asm volatile("s_waitcnt vmcnt(0)" ::: "memory");
  __syncthreads();
#undef G256_ISSUE
  const int rbase = m0 + wm * 128 + fr;
  const int cbase = n0 + wn * 64 + 4 * fq;
  if (EPI == EPI_SWIGLU) {
#pragma unroll
    for (int mi = 0; mi < 8; ++mi) {
      const int rl = wm * 128 + mi * 16 + fr;
#pragma unroll
      for (int nj = 0; nj < 2; ++nj) {
        const int fl = wn * 32 + nj * 16 + 4 * fq;
        const f32x4 g = acc[mi][2 * nj], u = acc[mi][2 * nj + 1];
        uint2 pk;
        pk.x = pack2(silu_f(g[0]) * u[0], silu_f(g[1]) * u[1]);
        pk.y = pack2(silu_f(g[2]) * u[2], silu_f(g[3]) * u[3]);
        *(uint2*)(lds + rl * 272 + fl * 2) = pk;
      }
    }
    __syncthreads();
    {
      bf16_t* dst = e.ob + (size_t)m0 * FF + (n0 >> 1);
#pragma unroll
      for (int i = 0; i < 8; ++i) {
        const int c = tid + 512 * i;
        const int rl = c >> 4, ch = c & 15;
        const uint4 v = *(const uint4*)(lds + rl * 272 + ch * 16);
        *(uint4*)(dst + (size_t)rl * FF + ch * 8) = v;
      }
    }
    __syncthreads();
  } else if (EPI == EPI_RESID) {
    const int grp = (m0 < SEQ) ? 0 : ((m0 < MLAT) ? 1 : 2);
#pragma unroll
    for (int ni = 0; ni < 4; ++ni) {
      const int col = cbase + ni * 16;
      float4 g = *(const float4*)(e.gate + grp * 9216 + col);
      g.x *= e.coef; g.y *= e.coef; g.z *= e.coef; g.w *= e.coef;
      float4 bv = make_float4(0.f, 0.f, 0.f, 0.f);
      if (e.bias && part == 0) bv = *(const float4*)(e.bias + col);
#pragma unroll
      for (int mi = 0; mi < 8; ++mi) {
        const int row = rbase + mi * 16;
        const size_t idx = (size_t)row * D + col;
        const f32x4 a = acc[mi][ni];
        if (e.atomic) {
          float4 o4;
          o4.x = g.x * (a[0] + bv.x); o4.y = g.y * (a[1] + bv.y); o4.z = g.z * (a[2] + bv.z); o4.w = g.w * (a[3] + bv.w);
          *(float4*)(e.part + ((size_t)part * 512 + (row - MLAT)) * D + col) = o4;
        } else {
          float4 s4 = *(const float4*)(e.Sin + idx);
          s4.x += g.x * (a[0] + bv.x); s4.y += g.y * (a[1] + bv.y); s4.z += g.z * (a[2] + bv.z); s4.w += g.w * (a[3] + bv.w);
          *(float4*)(e.S + idx) = s4;
          if (e.out2 && row < MLAT) *(float4*)(e.out2 + idx) = s4;
        }
      }
    }
  } else if (EPI == EPI_QK) {
    const int hcol0 = n0 + wn * 64;
    const bool isq = hcol0 < 1024;
    const float* nw = isq ? e.qn : e.kn;
    float4 nwv[4];
#pragma unroll
    for (int ni = 0; ni < 4; ++ni) nwv[ni] = *(const float4*)(nw + ni * 16 + 4 * fq);
    float freq[4];
#pragma unroll
    for (int i = 0; i < 4; ++i) freq[i] = exp2f(-(float)(4 * fq + i) * (13.287712379549449f / 16.f)) * 0.15915494309189535f;
    const float qs = isq ? (0.125f * 1.4426950408889634f) : 1.f;
#pragma unroll
    for (int mi = 0; mi < 8; ++mi) {
      const int row = rbase + mi * 16;
      f32x4 v[4];
      float ss = 0.f;
#pragma unroll
      for (int ni = 0; ni < 4; ++ni) { v[ni] = acc[mi][ni]; ss += v[ni][0] * v[ni][0] + v[ni][1] * v[ni][1] + v[ni][2] * v[ni][2] + v[ni][3] * v[ni][3]; }
      ss += __shfl_xor(ss, 16); ss += __shfl_xor(ss, 32);
      const float rstd = rsqrtf(ss * (1.f / 64.f) + EPSN);
#pragma unroll
      for (int ni = 0; ni < 4; ++ni) {
        v[ni][0] *= rstd * nwv[ni].x; v[ni][1] *= rstd * nwv[ni].y; v[ni][2] *= rstd * nwv[ni].z; v[ni][3] *= rstd * nwv[ni].w;
      }
      if (row < MLAT) {
        const int t = row & (SEQ - 1);
        const float pr = (float)(t >> 6), pc = (float)(t & 63);
#pragma unroll
        for (int i = 0; i < 4; ++i) {
          const float ar = pr * freq[i], ac = pc * freq[i];
          const float cr = __builtin_amdgcn_cosf(ar), sr = __builtin_amdgcn_sinf(ar);
          const float cc = __builtin_amdgcn_cosf(ac), sc = __builtin_amdgcn_sinf(ac);
          const float a0 = v[0][i] * cr - v[1][i] * sr, a1 = v[0][i] * sr + v[1][i] * cr;
          const float a2 = v[2][i] * cc - v[3][i] * sc, a3 = v[2][i] * sc + v[3][i] * cc;
          v[0][i] = a0; v[1][i] = a1; v[2][i] = a2; v[3][i] = a3;
        }
      }
      bf16_t* dst;
      if (isq) dst = e.q + (size_t)row * D + hcol0 + 4 * fq;
      else {
        const int kvh = (hcol0 - 1024) >> 6;
        int b, pos;
        if (row < MLAT) { b = row >> 13; pos = CTXL + (row & (SEQ - 1)); }
        else { b = (row - MLAT) >> 8; pos = (row - MLAT) & 255; }
        dst = e.kb + ((size_t)(b * 4 + kvh) * NKEY + pos) * 64 + 4 * fq;
      }
#pragma unroll
      for (int ni = 0; ni < 4; ++ni) {
        uint2 pk;
        pk.x = pack2(v[ni][0] * qs, v[ni][1] * qs);
        pk.y = pack2(v[ni][2] * qs, v[ni][3] * qs);
        *(uint2*)(dst + ni * 16) = pk;
      }
    }
  } else if (EPI == EPI_T) {
#pragma unroll
    for (int ni = 0; ni < 4; ++ni) {
      const int tok = cbase + ni * 16;
      size_t cm = (size_t)tok;
      if (e.vmode) {
        int b, pos;
        if (tok < MLAT) { b = tok >> 13; pos = CTXL + (tok & (SEQ - 1)); }
        else { b = (tok - MLAT) >> 8; pos = (tok - MLAT) & 255; }
        cm = (size_t)b * 256 * NKEY + pos;
      }
#pragma unroll
      for (int mi = 0; mi < 8; ++mi) {
        const int row = rbase + mi * 16;
        const float bv = e.bias ? e.bias[row] : 0.f;
        const f32x4 a = acc[mi][ni];
        uint2 pk;
        pk.x = pack2(a[0] + bv, a[1] + bv);
        pk.y = pack2(a[2] + bv, a[3] + bv);
        *(uint2*)(e.ob + (size_t)row * e.ldo + cm) = pk;
      }
    }
  } else if (EPI == EPI_FILT) {
#pragma unroll
    for (int mi = 0; mi < 8; ++mi) {
      const int row = rbase + mi * 16;
      const int d = row & 1023;
      const float delta = fabsf(-3.0701134573253945f + (float)d * ((-15.350567286626973f + 3.0701134573253945f) / 1023.f));
      const float dk = -delta * (1.f / 8191.f);
#pragma unroll
      for (int ni = 0; ni < 4; ++ni) {
        const int t = cbase + ni * 16;
        const f32x4 a = acc[mi][ni];
        uint2 pk;
        pk.x = pack2(a[0] * __expf((float)t * dk), a[1] * __expf((float)(t + 1) * dk));
        pk.y = pack2(a[2] * __expf((float)(t + 2) * dk), a[3] * __expf((float)(t + 3) * dk));
        *(uint2*)(e.ob + (size_t)row * SEQ + t) = pk;
      }
    }
  }
}

template <int EPI>
__device__ __forceinline__ void gemm256_phase(const bf16_t* A, const bf16_t* Bt, int ld, int nkt, int MT, int NTn, char* lds, const Epi& e, int rot) {
  const int G = gridDim.x;
  const int total = MT * NTn;
  int bid = (int)((blockIdx.x + G - (rot % G)) % G);
  if ((G & 7) == 0) bid = (bid & 7) * (G >> 3) + (bid >> 3);
  for (int u = bid; u < total; u += G) {
    const int band = u / (8 * NTn);
    const int rem = u - band * 8 * NTn;
    const int gsz = min(8, MT - band * 8);
    const int nt = rem / gsz, mt = band * 8 + (rem - nt * gsz);
    gemm256_tile<EPI>(A, Bt, ld, 0, nkt, mt * 256, nt * 256, lds, e, 0);
  }
}

__device__ __forceinline__ void convert_matrix(const float* src, int K, int N, bf16_t* dst, int perm, char* lds, int& rot) {
  const int G = gridDim.x, tid = tid_();
  const int tn = N >> 8, tk = K >> 6, total = tn * tk;
  bf16_t* T = (bf16_t*)lds;
  const int kr0 = tid >> 6, c4 = tid & 63;
  int t = (int)((blockIdx.x + G - (rot % G)) % G);
  float4 v[8];
  if (t < total) {
    const int kt = t / tn, ntile = t - kt * tn;
    const float* g = src + (size_t)((kt << 6) + kr0) * N + (ntile << 8) + c4 * 4;
#pragma unroll
    for (int i = 0; i < 8; ++i) v[i] = *(const float4*)(g + (size_t)(8 * i) * N);
  }
  for (; t < total; t += G) {
    const int kt = t / tn, ntile = t - kt * tn;
    const int k0 = kt << 6, n0 = ntile << 8;
#pragma unroll
    for (int i = 0; i < 8; ++i) {
      const int kr = kr0 + 8 * i;
      T[(c4 * 4 + 0) * 72 + kr] = f2bf(v[i].x);
      T[(c4 * 4 + 1) * 72 + kr] = f2bf(v[i].y);
      T[(c4 * 4 + 2) * 72 + kr] = f2bf(v[i].z);
      T[(c4 * 4 + 3) * 72 + kr] = f2bf(v[i].w);
    }
    const int t2 = t + G;
    if (t2 < total) {
      const int kt2 = t2 / tn, nt2 = t2 - kt2 * tn;
      const float* g = src + (size_t)((kt2 << 6) + kr0) * N + (nt2 << 8) + c4 * 4;
#pragma unroll
      for (int i = 0; i < 8; ++i) v[i] = *(const float4*)(g + (size_t)(8 * i) * N);
    }
    __syncthreads();
#pragma unroll
    for (int i = 0; i < 4; ++i) {
      const int idx = tid + 512 * i;
      const int n = idx >> 3, ch = idx & 7;
      const uint4 o = *(const uint4*)(T + n * 72 + ch * 8);
      int ng = n0 + n;
      if (perm) {
        if (ng < FF) ng = ((ng >> 4) << 5) + (ng & 15);
        else { const int f = ng - FF; ng = ((f >> 4) << 5) + 16 + (f & 15); }
      }
      *(uint4*)(dst + (size_t)ng * K + k0 + ch * 8) = o;
    }
    __syncthreads();
  }
  rot += total;
}

__device__ __forceinline__ void p0_prologue(const Params& p, char* lds) {
  const int G = gridDim.x, tid = tid_(), lane = tid & 63, w = tid >> 6;
  char* ws = p.ws;
  {
    float4* S4 = (float4*)(ws + OFF_S);
    const float4* x4 = (const float4*)p.in[0];
    const float4* c4 = (const float4*)p.in[2];
    const size_t nlat = (size_t)MLAT * D / 4, nall = (size_t)MALL * D / 4;
    (void)x4;
    for (size_t i = nlat + (size_t)blockIdx.x * NTHR + tid; i < nall; i += (size_t)G * NTHR)
      S4[i] = c4[i - nlat];
  }
  {
    float* MOD = (float*)(ws + OFF_MOD);
    const float* c = p.in[1];
    const float* cc = p.in[3];
    float* red = (float*)lds;
    for (int it = blockIdx.x; it < 4 * 144; it += G) {
      const int l = it / 144, c0 = (it - l * 144) * 64;
      const int cg4 = lane & 15, kq = lane >> 4;
      float a[3][4];
#pragma unroll
      for (int g = 0; g < 3; ++g)
#pragma unroll
        for (int j = 0; j < 4; ++j) a[g][j] = 0.f;
      const float* wb = p.in[4] + (size_t)l * D * 9216 + c0 + cg4 * 4;
#pragma unroll 4
      for (int i = 0; i < 32; ++i) {
        const int k = w * 128 + i * 4 + kq;
        const float4 wv = *(const float4*)(wb + (size_t)k * 9216);
        const float s0 = silu_f(c[k]), s1 = silu_f(c[D + k]), s2 = silu_f(cc[k]);
        a[0][0] += s0 * wv.x; a[0][1] += s0 * wv.y; a[0][2] += s0 * wv.z; a[0][3] += s0 * wv.w;
        a[1][0] += s1 * wv.x; a[1][1] += s1 * wv.y; a[1][2] += s1 * wv.z; a[1][3] += s1 * wv.w;
        a[2][0] += s2 * wv.x; a[2][1] += s2 * wv.y; a[2][2] += s2 * wv.z; a[2][3] += s2 * wv.w;
      }
#pragma unroll
      for (int g = 0; g < 3; ++g)
#pragma unroll
        for (int j = 0; j < 4; ++j) {
          float v = a[g][j];
          v += __shfl_xor(v, 16); v += __shfl_xor(v, 32);
          a[g][j] = v;
        }
      if (kq == 0) {
#pragma unroll
        for (int g = 0; g < 3; ++g)
#pragma unroll
          for (int j = 0; j < 4; ++j) red[(w * 3 + g) * 64 + cg4 * 4 + j] = a[g][j];
      }
      __syncthreads();
      if (tid < 192) {
        const int g = tid >> 6, col = tid & 63;
        float s = 0.f;
#pragma unroll
        for (int ww = 0; ww < 8; ++ww) s += red[(ww * 3 + g) * 64 + col];
        MOD[(size_t)(l * 3 + g) * 9216 + c0 + col] = s + p.in[5][(size_t)l * 9216 + c0 + col];
      }
      __syncthreads();
    }
  }
  {
    int rot = 0;
    for (int i = 0; i < 8; ++i) convert_matrix(p.in[7] + (size_t)i * D * NGU, D, NGU, (bf16_t*)(ws + OFF_WGU) + (size_t)i * NGU * D, 1, lds, rot);
    for (int i = 0; i < 8; ++i) convert_matrix(p.in[8] + (size_t)i * FF * D, FF, D, (bf16_t*)(ws + OFF_WD) + (size_t)i * D * FF, 0, lds, rot);
    for (int i = 0; i < 2; ++i) convert_matrix(p.in[9] + (size_t)i * D * 1536, D, 1536, (bf16_t*)(ws + OFF_WQKV) + (size_t)i * 1536 * D, 0, lds, rot);
    for (int i = 0; i < 2; ++i) convert_matrix(p.in[10] + (size_t)i * D * D, D, D, (bf16_t*)(ws + OFF_WO) + (size_t)i * D * D, 0, lds, rot);
    for (int i = 0; i < 2; ++i) convert_matrix(p.in[13] + (size_t)i * D * 3072, D, 3072, (bf16_t*)(ws + OFF_WIN) + (size_t)i * 3072 * D, 0, lds, rot);
    for (int i = 0; i < 2; ++i) convert_matrix(p.in[26] + (size_t)i * D * D, D, D, (bf16_t*)(ws + OFF_WHO) + (size_t)i * D * D, 0, lds, rot);
    for (int i = 0; i < 2; ++i) convert_matrix(p.in[23] + (size_t)i * 64 * 4096, 64, 4096, (bf16_t*)(ws + OFF_WOUTT) + (size_t)i * 4096 * 64, 0, lds, rot);
  }
  {
    float* W1 = (float*)lds;
    float* W2 = W1 + 33 * 64;
    float* W3 = W2 + 64 * 64;
    float* feat = W3 + 64 * 64;
    float* h1 = feat + 8 * 40;
    float* h2 = h1 + 8 * 64;
    const int tt = tid >> 6, h = tid & 63;
    const int per = 256 + 8;
    int jcur = -1;
    for (int it = blockIdx.x; it < 2 * per; it += G) {
      const int j = it / per;
      int r = it - j * per;
      const int Lsel = (r >= 256);
      if (Lsel) r -= 256;
      const int L = Lsel ? 256 : 8192;
      if (j != jcur) {
        __syncthreads();
        for (int i = tid; i < 33 * 64; i += NTHR) W1[i] = p.in[17][(size_t)j * 33 * 64 + i];
        for (int i = tid; i < 64 * 64; i += NTHR) { W2[i] = p.in[19][(size_t)j * 4096 + i]; W3[i] = p.in[21][(size_t)j * 4096 + i]; }
        jcur = j;
        __syncthreads();
      }
      const float a = p.in[24][j * 64 + h];
      const float b1 = p.in[18][j * 64 + h], b2 = p.in[20][j * 64 + h], b3 = p.in[22][j * 64 + h];
      for (int sub = 0; sub < 4; ++sub) {
        const int t = r * 32 + sub * 8 + tt;
        if (h < 33) {
          const float tl = (float)t / (float)(L - 1);
          const float wv = (6.2831855f * (float)t) / (float)L;
          float f;
          if (h == 0) f = tl;
          else {
            const int bi = (h - 1) & 15;
            const float band = 1e-4f + (float)bi * ((15.f - 1e-4f) / 15.f);
            const float ang = band * wv;
            f = (h <= 16) ? __cosf(ang) : -__sinf(ang);
          }
          feat[tt * 40 + h] = f;
        }
        __syncthreads();
        {
          float s = b1;
#pragma unroll
          for (int e2 = 0; e2 < 33; ++e2) s += feat[tt * 40 + e2] * W1[e2 * 64 + h];
          h1[tt * 64 + h] = __sinf(a * s);
        }
        __syncthreads();
        {
          float s = b2;
#pragma unroll 16
          for (int k = 0; k < 64; ++k) s += h1[tt * 64 + k] * W2[k * 64 + h];
          h2[tt * 64 + h] = __sinf(a * s);
        }
        __syncthreads();
        {
          float s = b3;
#pragma unroll 16
          for (int k = 0; k < 64; ++k) s += h2[tt * 64 + k] * W3[k * 64 + h];
          const float v = __sinf(a * s);
          if (Lsel) ((float*)(ws + OFF_HID3C))[((size_t)j * 256 + t) * 64 + h] = v;
          else ((bf16_t*)(ws + OFF_HID3))[((size_t)j * 8192 + t) * 64 + h] = f2bf(v);
        }
      }
    }
    __syncthreads();
  }
}

__device__ __forceinline__ void normmod_phase(const Params& p, int l, int k, int rows, int nparts) {
  const int G = gridDim.x, tid = tid_(), lane = tid & 63, w = tid >> 6;
  float* S = (float*)(p.ws + OFF_S);
  const float* PART = (const float*)(p.ws + OFF_PART);
  bf16_t* HB = (bf16_t*)(p.ws + OFF_HB);
  const float* MOD = (const float*)(p.ws + OFF_MOD) + (size_t)l * 3 * 9216;
  const float* nw = p.in[6] + (size_t)(l * 3 + k) * D;
  const int stride = G * 8;
  for (int row0 = blockIdx.x * 8 + w; row0 < rows; row0 += 2 * stride) {
    float4 x[2][4];
    float ss[2] = {0.f, 0.f};
#pragma unroll
    for (int rr = 0; rr < 2; ++rr) {
      const int row = row0 + rr * stride;
      if (row < rows) {
#pragma unroll
        for (int q = 0; q < 4; ++q) x[rr][q] = *(const float4*)(((l == 0 && k == 0 && row < MLAT) ? p.in[0] : (const float*)S) + (size_t)row * D + q * 256 + lane * 4);
      } else {
#pragma unroll
        for (int q = 0; q < 4; ++q) x[rr][q] = make_float4(0.f, 0.f, 0.f, 0.f);
      }
    }
#pragma unroll
    for (int rr = 0; rr < 2; ++rr) {
      const int row = row0 + rr * stride;
      if (row < rows && row >= MLAT && nparts > 0) {
#pragma unroll
        for (int q = 0; q < 4; ++q) {
          for (int pp = 0; pp < nparts; ++pp) {
            const float4 t4 = *(const float4*)(PART + ((size_t)pp * 512 + (row - MLAT)) * D + q * 256 + lane * 4);
            x[rr][q].x += t4.x; x[rr][q].y += t4.y; x[rr][q].z += t4.z; x[rr][q].w += t4.w;
          }
          *(float4*)(S + (size_t)row * D + q * 256 + lane * 4) = x[rr][q];
        }
      }
#pragma unroll
      for (int q = 0; q < 4; ++q) ss[rr] += x[rr][q].x * x[rr][q].x + x[rr][q].y * x[rr][q].y + x[rr][q].z * x[rr][q].z + x[rr][q].w * x[rr][q].w;
    }
#pragma unroll
    for (int o = 1; o < 64; o <<= 1) { ss[0] += __shfl_xor(ss[0], o); ss[1] += __shfl_xor(ss[1], o); }
#pragma unroll
    for (int rr = 0; rr < 2; ++rr) {
      const int row = row0 + rr * stride;
      if (row < rows) {
        const int grp = (row < SEQ) ? 0 : ((row < MLAT) ? 1 : 2);
        const float* sh = MOD + grp * 9216 + (3 * k) * D;
        const float* sc = sh + D;
        const float rstd = rsqrtf(ss[rr] * (1.f / 1024.f) + EPSN);
#pragma unroll
        for (int q = 0; q < 4; ++q) {
          const int c = q * 256 + lane * 4;
          const float4 g = *(const float4*)(nw + c);
          const float4 s1 = *(const float4*)(sc + c);
          const float4 s0 = *(const float4*)(sh + c);
          uint2 pk;
          pk.x = pack2(x[rr][q].x * rstd * g.x * (1.f + s1.x) + s0.x, x[rr][q].y * rstd * g.y * (1.f + s1.y) + s0.y);
          pk.y = pack2(x[rr][q].z * rstd * g.z * (1.f + s1.z) + s0.z, x[rr][q].w * rstd * g.w * (1.f + s1.w) + s0.w);
          *(uint2*)(HB + (size_t)row * D + c) = pk;
        }
      }
    }
  }
}

__device__ __forceinline__ void attention_phase(const Params& p, int ai, char* lds) {
  const int G = gridDim.x, tid = tid_(), lane = tid & 63, w = tid >> 6;
  const int l31 = lane & 31, hh = lane >> 5;
  const bf16_t* Q = (const bf16_t*)(p.ws + OFF_Q);
  const bf16_t* KB = (const bf16_t*)(p.ws + OFF_KB);
  const bf16_t* VT = (const bf16_t*)(p.ws + OFF_VT);
  bf16_t* OB = (bf16_t*)(p.ws + OFF_OB);
  const int lrow = tid >> 3, lch = tid & 7;
  float sbound;
  {
    float mq = fabsf(p.in[11][ai * 64 + lane]), mk = fabsf(p.in[12][ai * 64 + lane]);
#pragma unroll
    for (int o = 1; o < 64; o <<= 1) { mq = fmaxf(mq, __shfl_xor(mq, o)); mk = fmaxf(mk, __shfl_xor(mk, o)); }
    sbound = fminf(8.f * mq * mk * 1.4426950408889634f, 100.f);
  }
  for (int it = blockIdx.x; it < 1024 + 32; it += G) {
    int b, head, rowbase, nT;
    if (it < 1024) { b = it >> 9; head = (it >> 5) & 15; rowbase = b * SEQ + (it & 31) * 256; nT = NKEY / 64; }
    else { const int r = it - 1024; b = r >> 4; head = r & 15; rowbase = MLAT + b * CTXL; nT = CTXL / 64; }
    const int kvh = head >> 2;
    const bf16_t* kp = KB + ((size_t)(b * 4 + kvh) * NKEY + lrow) * 64 + lch * 8;
    const bf16_t* vp = VT + ((size_t)(b * 4 + kvh) * 64 + lrow) * NKEY + lch * 8;
    bf16x8 qf[4];
    {
      const bf16_t* qp = Q + (size_t)(rowbase + w * 32 + l31) * D + head * 64 + hh * 8;
#pragma unroll
      for (int ks = 0; ks < 4; ++ks) qf[ks] = *(const bf16x8*)(qp + ks * 16);
    }
    f32x16 o0, o1;
#pragma unroll
    for (int i = 0; i < 16; ++i) { o0[i] = 0.f; o1[i] = 0.f; }
    f32x16 negm;
#pragma unroll
    for (int i = 0; i < 16; ++i) negm[i] = -sbound;
    float lsa = 0.f, lsb = 0.f;
    uint4 rk = *(const uint4*)(kp);
    uint4 rv = *(const uint4*)(vp);
    *(uint4*)(lds + swz(lrow, lch)) = rk;
    *(uint2*)(lds + 16384 + lrow * 136 + lch * 16) = make_uint2(rv.x, rv.y);
    *(uint2*)(lds + 16384 + lrow * 136 + lch * 16 + 8) = make_uint2(rv.z, rv.w);
    __syncthreads();
    for (int kt = 0; kt < nT; ++kt) {
      char* cK = lds + (kt & 1) * 8192;
      char* cV = lds + 16384 + (kt & 1) * 8704;
      const bool more = (kt + 1 < nT);
      if (more) {
        rk = *(const uint4*)(kp + (size_t)(kt + 1) * 64 * 64);
        rv = *(const uint4*)(vp + (kt + 1) * 64);
      }
      f32x16 s0, s1;
      {
        const bf16x8 a0 = *(const bf16x8*)(cK + swz(l31, hh));
        const bf16x8 a1 = *(const bf16x8*)(cK + swz(l31 + 32, hh));
        s0 = __builtin_amdgcn_mfma_f32_32x32x16_bf16(a0, qf[0], negm, 0, 0, 0);
        s1 = __builtin_amdgcn_mfma_f32_32x32x16_bf16(a1, qf[0], negm, 0, 0, 0);
      }
#pragma unroll
      for (int ks = 1; ks < 4; ++ks) {
        const bf16x8 a0 = *(const bf16x8*)(cK + swz(l31, 2 * ks + hh));
        const bf16x8 a1 = *(const bf16x8*)(cK + swz(l31 + 32, 2 * ks + hh));
        s0 = __builtin_amdgcn_mfma_f32_32x32x16_bf16(a0, qf[ks], s0, 0, 0, 0);
        s1 = __builtin_amdgcn_mfma_f32_32x32x16_bf16(a1, qf[ks], s1, 0, 0, 0);
      }
#pragma unroll
      for (int i = 0; i < 16; i += 2) {
        s0[i] = __builtin_amdgcn_exp2f(s0[i]); s0[i + 1] = __builtin_amdgcn_exp2f(s0[i + 1]);
        s1[i] = __builtin_amdgcn_exp2f(s1[i]); s1[i + 1] = __builtin_amdgcn_exp2f(s1[i + 1]);
        lsa += s0[i] + s1[i];
        lsb += s0[i + 1] + s1[i + 1];
      }
      bf16x8 pf[4];
#pragma unroll
      for (int j = 0; j < 4; ++j) {
        u32x4 cv;
#pragma unroll
        for (int q2 = 0; q2 < 4; ++q2) {
          const int i0 = 8 * (j & 1) + 2 * q2;
          const float x0 = (j < 2) ? s0[i0] : s1[i0];
          const float x1 = (j < 2) ? s0[i0 + 1] : s1[i0 + 1];
          cv[q2] = cvt_pk_bf16(x0, x1);
        }
        pf[j] = __builtin_bit_cast(bf16x8, cv);
      }
#pragma unroll
      for (int j = 0; j < 4; ++j) {
        const char* r0 = cV + l31 * 136 + j * 32 + hh * 8;
        const char* r1 = cV + (l31 + 32) * 136 + j * 32 + hh * 8;
        const uint2 x0 = *(const uint2*)(r0), x1 = *(const uint2*)(r0 + 16);
        const uint2 y0 = *(const uint2*)(r1), y1 = *(const uint2*)(r1 + 16);
        const u32x4 v0 = {x0.x, x0.y, x1.x, x1.y};
        const u32x4 v1 = {y0.x, y0.y, y1.x, y1.y};
        o0 = __builtin_amdgcn_mfma_f32_32x32x16_bf16(__builtin_bit_cast(bf16x8, v0), pf[j], o0, 0, 0, 0);
        o1 = __builtin_amdgcn_mfma_f32_32x32x16_bf16(__builtin_bit_cast(bf16x8, v1), pf[j], o1, 0, 0, 0);
      }
      if (more) {
        char* nK = lds + ((kt + 1) & 1) * 8192;
        char* nV = lds + 16384 + ((kt + 1) & 1) * 8704;
        *(uint4*)(nK + swz(lrow, lch)) = rk;
        *(uint2*)(nV + lrow * 136 + lch * 16) = make_uint2(rv.x, rv.y);
        *(uint2*)(nV + lrow * 136 + lch * 16 + 8) = make_uint2(rv.z, rv.w);
      }
      __syncthreads();
    }
    float lsum = lsa + lsb;
    lsum += __shfl_xor(lsum, 32);
    const float inv = 1.f / lsum;
    bf16_t* op = OB + (size_t)(rowbase + w * 32 + l31) * D + head * 64 + hh * 4;
#pragma unroll
    for (int g4 = 0; g4 < 4; ++g4) {
      uint2 pk;
      pk.x = pack2(o0[g4 * 4 + 0] * inv, o0[g4 * 4 + 1] * inv);
      pk.y = pack2(o0[g4 * 4 + 2] * inv, o0[g4 * 4 + 3] * inv);
      *(uint2*)(op + g4 * 8) = pk;
      pk.x = pack2(o1[g4 * 4 + 0] * inv, o1[g4 * 4 + 1] * inv);
      pk.y = pack2(o1[g4 * 4 + 2] * inv, o1[g4 * 4 + 3] * inv);
      *(uint2*)(op + 32 + g4 * 8) = pk;
    }
  }
}

__device__ __forceinline__ void dft16(float2 (&v)[16]) {
  float2 t[4][4];
#pragma unroll
  for (int a = 0; a < 4; ++a) {
    const float2 x0 = v[a], x1 = v[a + 4], x2 = v[a + 8], x3 = v[a + 12];
    const float2 s0 = make_float2(x0.x + x2.x, x0.y + x2.y), s1 = make_float2(x0.x - x2.x, x0.y - x2.y);
    const float2 s2 = make_float2(x1.x + x3.x, x1.y + x3.y), s3 = make_float2(x1.x - x3.x, x1.y - x3.y);
    t[a][0] = make_float2(s0.x + s2.x, s0.y + s2.y);
    t[a][1] = make_float2(s1.x + s3.y, s1.y - s3.x);
    t[a][2] = make_float2(s0.x - s2.x, s0.y - s2.y);
    t[a][3] = make_float2(s1.x - s3.y, s1.y + s3.x);
  }
  const float C1 = 0.92387953251128674f, S1 = 0.38268343236508977f, R2 = 0.70710678118654752f;
  t[1][1] = cmul(t[1][1], make_float2(C1, -S1));
  t[1][2] = cmul(t[1][2], make_float2(R2, -R2));
  t[1][3] = cmul(t[1][3], make_float2(S1, -C1));
  t[2][1] = cmul(t[2][1], make_float2(R2, -R2));
  t[2][2] = make_float2(t[2][2].y, -t[2][2].x);
  t[2][3] = cmul(t[2][3], make_float2(-R2, -R2));
  t[3][1] = cmul(t[3][1], make_float2(S1, -C1));
  t[3][2] = cmul(t[3][2], make_float2(-R2, -R2));
  t[3][3] = cmul(t[3][3], make_float2(-C1, S1));
#pragma unroll
  for (int c = 0; c < 4; ++c) {
    const float2 x0 = t[0][c], x1 = t[1][c], x2 = t[2][c], x3 = t[3][c];
    const float2 s0 = make_float2(x0.x + x2.x, x0.y + x2.y), s1 = make_float2(x0.x - x2.x, x0.y - x2.y);
    const float2 s2 = make_float2(x1.x + x3.x, x1.y + x3.y), s3 = make_float2(x1.x - x3.x, x1.y - x3.y);
    v[c] = make_float2(s0.x + s2.x, s0.y + s2.y);
    v[c + 4] = make_float2(s1.x + s3.y, s1.y - s3.x);
    v[c + 8] = make_float2(s0.x - s2.x, s0.y - s2.y);
    v[c + 12] = make_float2(s1.x - s3.y, s1.y + s3.x);
  }
}

__device__ __forceinline__ void r16_pass(float2 (&r)[16], float2* buf, int tid, int Ns) {
  const int k = tid & (Ns - 1);
  if (Ns > 1) {
    const float2 w1 = cexp_rev(-(float)k / (float)(16 * Ns));
    float2 w = w1;
#pragma unroll
    for (int i = 1; i < 16; ++i) {
      r[i] = cmul(r[i], w);
      w = cmul(w, w1);
    }
  }
  dft16(r);
  const int j0 = ((tid - k) << 4) + k;
#pragma unroll
  for (int m = 0; m < 16; ++m) { const int ix = j0 + m * Ns; buf[ix + (ix >> 4)] = r[m]; }
}

__device__ __forceinline__ void fft8192(float2 (&r)[16], float2* buf, int tid) {
#pragma unroll
  for (int Ns = 1; Ns < 4096; Ns <<= 4) {
    r16_pass(r, buf, tid, Ns);
    __syncthreads();
#pragma unroll
    for (int i = 0; i < 16; ++i) { const int ix = tid + 512 * i; r[i] = buf[ix + (ix >> 4)]; }
    __syncthreads();
  }
#pragma unroll
  for (int b = 0; b < 8; ++b) {
    const int j = tid + 512 * b;
    const float2 a0 = r[b];
    const float2 a1 = cmul(r[b + 8], cexp_rev(-(float)j * (1.f / 8192.f)));
    r[b] = make_float2(a0.x + a1.x, a0.y + a1.y);
    r[b + 8] = make_float2(a0.x - a1.x, a0.y - a1.y);
  }
}

__device__ __forceinline__ void stage_rows(const bf16_t* r0, const bf16_t* r1, char* dst, int tid) {
#pragma unroll
  for (int i = 0; i < 4; ++i) {
    const int c = tid + 512 * i;
    const bf16_t* src = (c < 1024) ? (r0 + c * 8) : (r1 + (c - 1024) * 8);
    *(uint4*)(dst + c * 16) = *(const uint4*)src;
  }
}

__device__ __forceinline__ void hyena_conv_phase(const Params& p, int j, bool with_ctx, char* lds) {
  const int G = gridDim.x, tid = tid_();
  const bf16_t* U = (const bf16_t*)(p.ws + OFF_ACT);
  const bf16_t* FILT = (const bf16_t*)(p.ws + OFF_FILT);
  bf16_t* YT = (bf16_t*)(p.ws + OFF_YT);
  const float* cw = p.in[15] + (size_t)j * 3 * 3072;
  const float* cb = p.in[16] + (size_t)j * 3072;
  const float* fbias = p.in[25] + (size_t)j * 2 * D;
  float2* buf0 = (float2*)lds;
  float2* bufH = buf0 + 8704;
  const int nitems = with_ctx ? 2048 : 1024;
  for (int it = blockIdx.x; it < nitems; it += G) {
    if (it < 1024) {
      const int d = it;
      float2 acc[16], r[16], xr[16];
      unsigned* zE = (unsigned*)bufH;
      unsigned* zO = zE + 8192;
#pragma unroll 1
      for (int part = 0; part < 2; ++part) {
        int tq = threadIdx.x;
        asm volatile("" : "+v"(tq));
        stage_rows(FILT + (size_t)(0 * 1024 + d) * SEQ, FILT + (size_t)(1 * 1024 + d) * SEQ, lds, tq);
        stage_rows(FILT + (size_t)(2 * 1024 + d) * SEQ, FILT + (size_t)(3 * 1024 + d) * SEQ, lds + 32768, tq);
        __syncthreads();
        const bf16_t* st = (const bf16_t*)lds;
#pragma unroll
        for (int i = 0; i < 16; ++i) {
          const int n = tq + 512 * i;
          const int nb = (n == 0) ? 0 : (SEQ - n);
          const float f0 = bf2f(st[n]), g0 = bf2f(st[SEQ + nb]);
          const float f1 = bf2f(st[2 * SEQ + n]), g1 = bf2f(st[3 * SEQ + nb]);
          if (part == 0) r[i] = make_float2(f0 + g0, f1 + g1);
          else {
            const float d0 = (n == 0) ? (f0 + g0) : (f0 - g0);
            const float d1 = (n == 0) ? (f1 + g1) : (f1 - g1);
            r[i] = cmul(make_float2(d0, d1), cexp_rev(-(float)n * (1.f / 16384.f)));
          }
        }
        __syncthreads();
        fft8192(r, buf0, tq);
        unsigned* zz = part ? zO : zE;
#pragma unroll
        for (int i = 0; i < 16; ++i) zz[tq + 512 * i] = pack2(r[i].x, r[i].y);
      }
      __syncthreads();
      {
        int t0 = threadIdx.x;
        asm volatile("" : "+v"(t0));
        const bf16_t* u0 = U + (size_t)d * MALL;
        stage_rows(u0, u0 + SEQ, lds, t0);
        __syncthreads();
        const bf16_t* st = (const bf16_t*)lds;
        const float w0 = cw[d], w1 = cw[3072 + d], w2 = cw[6144 + d], bb = cb[d];
#pragma unroll
        for (int i = 0; i < 16; ++i) {
          const int n = t0 + 512 * i;
          float vv[2];
#pragma unroll
          for (int b = 0; b < 2; ++b) {
            const bf16_t* ub = st + b * SEQ + n;
            const float um0 = bf2f(ub[(n > 0) ? -1 : 0]);
            const float uc = bf2f(ub[0]);
            const float up0 = bf2f(ub[(n < SEQ - 1) ? 1 : 0]);
            const float um = (n > 0) ? um0 : 0.f;
            const float up = (n < SEQ - 1) ? up0 : 0.f;
            vv[b] = um * w0 + uc * w1 + up * w2 + bb;
          }
          xr[i] = make_float2(vv[0], vv[1]);
        }
        __syncthreads();
      }
#pragma unroll 1
      for (int o = 0; o < 2; ++o) {
#pragma unroll 1
        for (int step = 1; step < 6; ++step) {
          if (step == 3) continue;
          int tq = threadIdx.x;
          asm volatile("" : "+v"(tq));
          if (step == 1) {
#pragma unroll
            for (int i = 0; i < 16; ++i) r[i] = xr[i];
          } else if (step == 4) {
#pragma unroll
            for (int i = 0; i < 16; ++i) {
              const int n = tq + 512 * i;
              r[i] = cmul(xr[i], cexp_rev(-(float)n * (1.f / 16384.f)));
            }
          }
          fft8192(r, buf0, tq);
          if (step == 1 || step == 4) {
            const unsigned* zz = (step == 1) ? zE : zO;
#pragma unroll
            for (int i = 0; i < 16; ++i) {
              const int k = tq + 512 * i;
              const int km = (step == 1) ? ((SEQ - k) & (SEQ - 1)) : (SEQ - 1 - k);
              const unsigned za = zz[k], zb = zz[km];
              const float2 Z = make_float2(__uint_as_float(za << 16), __uint_as_float(za & 0xffff0000u));
              const float2 Zm = make_float2(__uint_as_float(zb << 16), -__uint_as_float(zb & 0xffff0000u));
              float2 H;
              if (o == 0) H = make_float2(0.5f * (Z.x + Zm.x), 0.5f * (Z.y + Zm.y));
              else H = make_float2(0.5f * (Z.y - Zm.y), -0.5f * (Z.x - Zm.x));
              const float2 y = cmul(r[i], H);
              r[i] = make_float2(y.x, -y.y);
            }
          } else if (step == 2) {
#pragma unroll
            for (int i = 0; i < 16; ++i) acc[i] = make_float2(r[i].x, -r[i].y);
          } else {
#pragma unroll
            for (int i = 0; i < 16; ++i) {
              const int n = tq + 512 * i;
              const float2 wc = cexp_rev((float)n * (1.f / 16384.f));
              const float2 io = make_float2(r[i].x, -r[i].y);
              const float2 y = cmul(wc, io);
              acc[i] = make_float2((acc[i].x + y.x) * (1.f / 16384.f), (acc[i].y + y.y) * (1.f / 16384.f));
            }
          }
        }
        const int gc = (o == 0) ? (1024 + d) : (2048 + d);
        const bf16_t* ug = U + (size_t)gc * MALL;
        const float w0 = cw[gc], w1 = cw[3072 + gc], w2 = cw[6144 + gc], bb = cb[gc];
        const float fb = fbias[o * D + d];
        int te = threadIdx.x;
        asm volatile("" : "+v"(te));
        stage_rows(ug, ug + SEQ, lds, te);
        __syncthreads();
        const bf16_t* stg = (const bf16_t*)lds;
#pragma unroll
        for (int i = 0; i < 16; ++i) {
          const int n = te + 512 * i;
          float gg[2];
#pragma unroll
          for (int b = 0; b < 2; ++b) {
            const bf16_t* ub = stg + b * SEQ + n;
            const float um0 = bf2f(ub[(n > 0) ? -1 : 0]);
            const float uc = bf2f(ub[0]);
            const float up0 = bf2f(ub[(n < SEQ - 1) ? 1 : 0]);
            const float um = (n > 0) ? um0 : 0.f;
            const float up = (n < SEQ - 1) ? up0 : 0.f;
            gg[b] = um * w0 + uc * w1 + up * w2 + bb;
          }
          const float2 xv = xr[i];
          const float z0 = gg[0] * (acc[i].x + xv.x * fb);
          const float z1 = gg[1] * (acc[i].y + xv.y * fb);
          if (o == 0) xr[i] = make_float2(z0, z1);
          else {
            YT[(size_t)d * MALL + n] = f2bf(z0);
            YT[(size_t)d * MALL + SEQ + n] = f2bf(z1);
          }
        }
        __syncthreads();
      }
    } else {
      const int d = it - 1024;
      const int tc = tid_();
      float* Fc = (float*)lds;
      float* zs = Fc + 1024;
      const float* hid = (const float*)(p.ws + OFF_HID3C) + (size_t)j * 256 * 64;
      const float* wout = p.in[23] + (size_t)j * 64 * 4096;
      const float delta = fabsf(-3.0701134573253945f + (float)d * ((-15.350567286626973f + 3.0701134573253945f) / 1023.f));
#pragma unroll
      for (int i = 0; i < 2; ++i) {
        const int idx = tc + 512 * i;
        const int od = idx >> 8, t = idx & 255;
        float s = 0.f;
        for (int h = 0; h < 64; ++h) s += hid[t * 64 + h] * wout[(size_t)h * 4096 + od * 1024 + d];
        Fc[idx] = s * __expf(-(float)t * (1.f / 255.f) * delta);
      }
      const int b = tc >> 8, t = tc & 255;
      float sc3[3];
#pragma unroll
      for (int c3 = 0; c3 < 3; ++c3) {
        const int col = c3 * 1024 + d;
        const bf16_t* ub = U + (size_t)col * MALL + MLAT + b * CTXL + t;
        const float um0 = bf2f(ub[(t > 0) ? -1 : 0]);
        const float uc = bf2f(ub[0]);
        const float up0 = bf2f(ub[(t < CTXL - 1) ? 1 : 0]);
        const float um = (t > 0) ? um0 : 0.f;
        const float up = (t < CTXL - 1) ? up0 : 0.f;
        sc3[c3] = um * cw[col] + uc * cw[3072 + col] + up * cw[6144 + col] + cb[col];
      }
      float zin = sc3[0];
#pragma unroll 1
      for (int o = 0; o < 2; ++o) {
        __syncthreads();
        zs[b * 256 + t] = zin;
        __syncthreads();
        const float* fwd = Fc + (o * 2) * 256;
        const float* bwd = fwd + 256;
        float a = 0.f;
        for (int s = 0; s < 256; ++s) {
          const int dd = t - s;
          const float tap = (dd > 0) ? fwd[dd] : ((dd < 0) ? bwd[-dd] : (fwd[0] + bwd[0]));
          a += tap * zs[b * 256 + s];
        }
        const float res = sc3[1 + o] * (a + zin * fbias[o * D + d]);
        if (o == 0) zin = res;
        else YT[(size_t)d * MALL + MLAT + b * CTXL + t] = f2bf(res);
      }
      __syncthreads();
    }
  }
}

__device__ __forceinline__ void transpose_y_phase(const Params& p, int ntok, char* lds) {
  const int G = gridDim.x, tid = tid_();
  const bf16_t* YT = (const bf16_t*)(p.ws + OFF_YT);
  bf16_t* YB = (bf16_t*)(p.ws + OFF_OB);
  unsigned* T = (unsigned*)lds;
  const int ntt = ntok >> 7;
  const int lane = tid & 63, w = tid >> 6;
  const int ch = lane >> 2, dp = (lane & 3) + 4 * w;
  for (int t = blockIdx.x; t < 16 * ntt; t += G) {
    const int dt = t / ntt, tt = t - dt * ntt;
    {
      const bf16_t* g = YT + (size_t)(dt * 64 + 2 * dp) * MALL + tt * 128 + ch * 8;
      const uint4 a = *(const uint4*)(g);
      const uint4 c = *(const uint4*)(g + MALL);
      unsigned* tp = T + (ch * 8) * 33 + dp;
      tp[0 * 33] = (a.x & 0xffffu) | (c.x << 16);  tp[1 * 33] = (a.x >> 16) | (c.x & 0xffff0000u);
      tp[2 * 33] = (a.y & 0xffffu) | (c.y << 16);  tp[3 * 33] = (a.y >> 16) | (c.y & 0xffff0000u);
      tp[4 * 33] = (a.z & 0xffffu) | (c.z << 16);  tp[5 * 33] = (a.z >> 16) | (c.z & 0xffff0000u);
      tp[6 * 33] = (a.w & 0xffffu) | (c.w << 16);  tp[7 * 33] = (a.w >> 16) | (c.w & 0xffff0000u);
    }
    __syncthreads();
#pragma unroll
    for (int i = 0; i < 2; ++i) {
      const int idx = tid + 512 * i;
      const int tk = idx >> 3, q = idx & 7;
      const unsigned* tp = T + tk * 33 + q * 4;
      uint4 o;
      o.x = tp[0]; o.y = tp[1]; o.z = tp[2]; o.w = tp[3];
      *(uint4*)(YB + (size_t)(tt * 128 + tk) * D + dt * 64 + q * 8) = o;
    }
    __syncthreads();
  }
}

#define XB_TMO      128
#define XB_XCNT(j)  (256  + 64 * (j))
#define XB_XSUB(j)  (1280 + 64 * (j))
#define XB_XGEN(j)  (2304 + 64 * (j))
#define XB_TOP      3328
#define XB_TOPGEN   3392
#define XCD_BAR_WORDS 3456
#define XB_SPIN_CAP (1u << 18)
#define LAS __attribute__((address_space(3)))

__device__ __forceinline__ unsigned xb_ld(unsigned* p)              { return __hip_atomic_load(p, __ATOMIC_RELAXED, __HIP_MEMORY_SCOPE_AGENT); }
__device__ __forceinline__ unsigned xb_add(unsigned* p, unsigned v) { return __hip_atomic_fetch_add(p, v, __ATOMIC_RELAXED, __HIP_MEMORY_SCOPE_AGENT); }
__device__ __forceinline__ unsigned xb_xcc_id() { return (unsigned)__builtin_amdgcn_s_getreg((3 << 11) | 20) & 0xFu; }
#define XB_SPIN(cond, bar) do { unsigned _sp = 0; while (cond) { __builtin_amdgcn_s_sleep(1); \
    if ((++_sp & 255u) == 0u) { if (xb_ld(&(bar)[XB_TMO])) break; if (_sp > XB_SPIN_CAP) { atomicAdd(&(bar)[XB_TMO], 1u); break; } } } } while (0)

struct XcdBarrier {
    unsigned* bar; unsigned x;
    volatile LAS unsigned* st;
};

__device__ __forceinline__ XcdBarrier xcd_barrier_post(unsigned* bar, volatile LAS unsigned* st) {
    XcdBarrier b; b.bar = bar; b.x = xb_xcc_id(); b.st = st;
    if (threadIdx.x == 0) (void)xb_add(&bar[XB_XCNT(b.x)], 1u);
    return b;
}
__device__ __forceinline__ void xcd_barrier_complete(unsigned* bar, unsigned x, unsigned& nloc, unsigned& nx) {
    const unsigned G = gridDim.x * gridDim.y * gridDim.z;
    unsigned sum, cnt, mine, sp = 0u;
    for (;;) {
        sum = 0u; cnt = 0u; mine = 0u;
#pragma unroll
        for (unsigned j = 0; j < 16; ++j) { const unsigned c = xb_ld(&bar[XB_XCNT(j)]); sum += c; cnt += (c > 0u) ? 1u : 0u; mine = (j == x) ? c : mine; }
        if (sum == G) break;
        __builtin_amdgcn_s_sleep(1);
        if ((++sp & 255u) == 0u) { if (xb_ld(&bar[XB_TMO])) break; if (sp > XB_SPIN_CAP) { atomicAdd(&bar[XB_TMO], 1u); break; } }
    }
    nloc = mine > 0u ? mine : 1u; nx = cnt > 0u ? cnt : 1u;
}

__device__ __forceinline__ void xcd_barrier(const XcdBarrier& b) {
    asm volatile("s_waitcnt vmcnt(0)" ::: "memory");
    __syncthreads();
    if (threadIdx.x == 0) {
        unsigned* bar = b.bar;
        __builtin_amdgcn_s_waitcnt(0);
        unsigned nloc = b.st[0], nx = b.st[1];
        if (nloc == 0u) { xcd_barrier_complete(bar, b.x, nloc, nx); b.st[0] = nloc; b.st[1] = nx; }
        const unsigned old = xb_add(&bar[XB_XSUB(b.x)], 1u);
        const unsigned gen = old / nloc;
        if (old + 1u == (gen + 1u) * nloc) {
            __builtin_amdgcn_fence(__ATOMIC_RELEASE, "agent");
            asm volatile("s_waitcnt vmcnt(0)" ::: "memory");
            const unsigned og = xb_add(&bar[XB_TOP], 1u);
            const unsigned tg = og / nx;
            if (og + 1u == (tg + 1u) * nx) xb_add(&bar[XB_TOPGEN], 1u);
            else XB_SPIN(xb_ld(&bar[XB_TOPGEN]) == tg, bar);
            __builtin_amdgcn_fence(__ATOMIC_ACQUIRE, "agent");
            xb_add(&bar[XB_XGEN(b.x)], 1u);
            asm volatile("s_waitcnt vmcnt(0)" ::: "memory");
        } else {
            XB_SPIN(xb_ld(&bar[XB_XGEN(b.x)]) == gen, bar);
            __builtin_amdgcn_fence(__ATOMIC_ACQUIRE, "agent");
            asm volatile("s_waitcnt vmcnt(0)" ::: "memory");
        }
    }
    __syncthreads();
}


__device__ __forceinline__ void grid_barrier(unsigned* ctr, unsigned target) {
  asm volatile("s_waitcnt vmcnt(0)" ::: "memory");
  __syncthreads();
  if (threadIdx.x == 0) {
    __builtin_amdgcn_fence(__ATOMIC_RELEASE, "agent");
    asm volatile("s_waitcnt vmcnt(0)" ::: "memory");
    __hip_atomic_fetch_add(ctr, 1u, __ATOMIC_RELAXED, __HIP_MEMORY_SCOPE_AGENT);
    while (__hip_atomic_load(ctr, __ATOMIC_RELAXED, __HIP_MEMORY_SCOPE_AGENT) < target) __builtin_amdgcn_s_sleep(1);
    __builtin_amdgcn_fence(__ATOMIC_ACQUIRE, "agent");
  }
  __syncthreads();
}

__global__ void __launch_bounds__(NTHR, 2) fwd_megakernel(Params p) {
  extern __shared__ __attribute__((aligned(16))) char lds[];
  cg::grid_group grid = cg::this_grid();
  {
    volatile LAS unsigned* xst = (volatile LAS unsigned*)(lds + 139248);
    if (threadIdx.x < 4) xst[threadIdx.x] = 0u;
    __syncthreads();
  }
  const XcdBarrier xbar = xcd_barrier_post((unsigned*)(p.ws + OFF_BAR), (volatile LAS unsigned*)(lds + 139248));
  char* ws = p.ws;
  unsigned nbar = 0;
  for (int ph = p.ph_lo; ph < p.ph_hi; ++ph) {
    int ptype = 8;
    if (ph > 0) {
      const int sub_ = (ph - 1) % 10, l_ = (ph - 1) / 10;
      ptype = (sub_ == 0 || sub_ == 3 || sub_ == 7) ? 0 : (sub_ == 1 || sub_ == 8) ? 1 : (sub_ == 2 || sub_ == 9) ? 2 : (sub_ == 6) ? 5 : (sub_ == 4) ? ((l_ & 1) ? 6 : 3) : ((l_ & 1) ? 7 : 4);
    }
    const int nrep = ((PROBE_MASK >> ptype) & 1) ? 2 : 1;
    for (int rep = 0; rep < nrep; ++rep) {
    if (rep > 0) { xcd_barrier(xbar); }
    if (ph == 0) {
      p0_prologue(p, lds);
    } else {
      const int l = (ph - 1) / 10, sub = (ph - 1) % 10;
      const bool is_attn = (l & 1) == 0;
      const int mi2 = l >> 1;
      const int rows = (l < 3) ? MALL : MLAT;
      const int MT = rows / 256;
      const float* MODL = (const float*)(ws + OFF_MOD) + (size_t)l * 3 * 9216;
      Epi e{};
      e.S = (float*)(ws + OFF_S);
      e.Sin = (l == 0 && sub == 2) ? p.in[0] : (const float*)(ws + OFF_S);
      if (sub == 0 || sub == 3 || sub == 7) {
        const int nparts = (sub == 0) ? ((l > 0) ? 11 : 0) : ((l < 3) ? ((sub == 3) ? 11 : 4) : 0);
        normmod_phase(p, l, sub == 0 ? 0 : (sub == 3 ? 1 : 2), rows, nparts);
      } else if (sub == 1 || sub == 8) {
        const int fi = l * 2 + (sub == 8);
        e.ob = (bf16_t*)(ws + OFF_ACT);
        gemm256_phase<EPI_SWIGLU>((const bf16_t*)(ws + OFF_HB), (const bf16_t*)(ws + OFF_WGU) + (size_t)fi * NGU * D, D, D / 64, MT, NGU / 256, lds, e, 0);
      } else if (sub == 2 || sub == 9 || sub == 6) {
        const bf16_t* A; const bf16_t* Bt; int K;
        e.out2 = nullptr; e.bias = nullptr;
        if (sub == 6) {
          if (!is_attn) {
            transpose_y_phase(p, rows, lds);
            xcd_barrier(xbar);
          }
          e.gate = MODL + 5 * D; e.coef = 1.f; K = D;
          A = (const bf16_t*)(ws + OFF_OB);
          if (is_attn) Bt = (const bf16_t*)(ws + OFF_WO) + (size_t)mi2 * D * D;
          else { Bt = (const bf16_t*)(ws + OFF_WHO) + (size_t)mi2 * D * D; e.bias = p.in[27] + (size_t)mi2 * D; }
        } else {
          const int fi = l * 2 + (sub == 9);
          e.gate = MODL + (sub == 2 ? 2 : 8) * D; e.coef = 0.5f; K = FF;
          A = (const bf16_t*)(ws + OFF_ACT);
          Bt = (const bf16_t*)(ws + OFF_WD) + (size_t)fi * D * FF;
          if (l == 3 && sub == 9) e.out2 = p.out;
        }
        if (rep + 1 < nrep) { e.coef = 0.f; e.out2 = nullptr; }
        const int nkt = K / 64;
        const int nlat = 256;
        const int nsplit = (l < 3) ? (nkt / 4) : 0;
        const int total = nlat + 8 * nsplit;
        const int G = gridDim.x;
        int bid = blockIdx.x;
        if ((G & 7) == 0) bid = (bid & 7) * (G >> 3) + (bid >> 3);
        for (int u = bid; u < total; u += G) {
          if (u < nlat) {
            e.atomic = 0;
            const int band = u >> 5, rem = u & 31;
            gemm256_tile<EPI_RESID>(A, Bt, K, 0, nkt, (band * 8 + (rem & 7)) * 256, (rem >> 3) * 256, lds, e, 0);
          } else {
            e.atomic = 1;
            e.part = (float*)(ws + OFF_PART);
            const int it = u - nlat;
            const int part = it >> 3, un = it & 7;
            gemm256_tile<EPI_RESID>(A, Bt, K, part * 4, 4, (64 + (un & 1)) * 256, (un >> 1) * 256, lds, e, part);
          }
        }
      } else if (sub == 4) {
        if (is_attn) {
          e.q = (bf16_t*)(ws + OFF_Q); e.kb = (bf16_t*)(ws + OFF_KB);
          e.qn = p.in[11] + mi2 * 64; e.kn = p.in[12] + mi2 * 64;
          const bf16_t* W = (const bf16_t*)(ws + OFF_WQKV) + (size_t)mi2 * 1536 * D;
          gemm256_phase<EPI_QK>((const bf16_t*)(ws + OFF_HB), W, D, D / 64, MT, 5, lds, e, 0);
          Epi e2{};
          e2.ob = (bf16_t*)(ws + OFF_VT); e2.ldo = NKEY; e2.vmode = 1; e2.bias = nullptr;
          gemm256_phase<EPI_T>(W + (size_t)1280 * D, (const bf16_t*)(ws + OFF_HB), D, D / 64, 1, MT, lds, e2, MT * 5);
        } else {
          Epi e2{};
          e2.ob = (bf16_t*)(ws + OFF_ACT); e2.ldo = MALL; e2.vmode = 0;
          e2.bias = p.in[14] + (size_t)mi2 * 3072;
          gemm256_phase<EPI_T>((const bf16_t*)(ws + OFF_WIN) + (size_t)mi2 * 3072 * D, (const bf16_t*)(ws + OFF_HB), D, D / 64, 12, MT, lds, e2, 0);
          Epi e3{};
          e3.ob = (bf16_t*)(ws + OFF_FILT);
          gemm256_phase<EPI_FILT>((const bf16_t*)(ws + OFF_WOUTT) + (size_t)mi2 * 4096 * 64, (const bf16_t*)(ws + OFF_HID3) + (size_t)mi2 * 8192 * 64, 64, 1, 16, 32, lds, e3, MT * 12);
        }
      } else if (sub == 5) {
        if (is_attn) attention_phase(p, mi2, lds);
        else hyena_conv_phase(p, mi2, l < 3, lds);
      }
    }
    }
    if (ph + 1 < p.ph_hi) {
      if (ph == 0) grid.sync();
      else { xcd_barrier(xbar); }
    }
  }
}

constexpr int LDS_BYTES = 139264;
constexpr int NPHASES = 41;

extern "C" void kernel_launch(void* const* d_in, const int* in_sizes, int n_in, void* d_out, int out_size,
                              void* d_ws, size_t ws_size, hipStream_t stream) {
  static int grid_blocks = 0;
  if (grid_blocks == 0) {
    if (ws_size < WS_END) { fprintf(stderr, "kernel_launch: workspace too small: %zu < %zu\n", ws_size, (size_t)WS_END); grid_blocks = -1; return; }
    int dev = 0, cus = 0, per_cu = 0;
    hipGetDevice(&dev);
    hipDeviceGetAttribute(&cus, hipDeviceAttributeMultiprocessorCount, dev);
    if (hipFuncSetAttribute((const void*)fwd_megakernel, hipFuncAttributeMaxDynamicSharedMemorySize, LDS_BYTES) != hipSuccess) {
      fprintf(stderr, "kernel_launch: hipFuncSetAttribute failed\n"); grid_blocks = -1; return;
    }
    hipOccupancyMaxActiveBlocksPerMultiprocessor(&per_cu, (const void*)fwd_megakernel, NTHR, LDS_BYTES);
    if (per_cu < 1) { fprintf(stderr, "kernel_launch: occupancy query says %d blocks/CU\n", per_cu); per_cu = 1; }
    grid_blocks = cus * 1;
    (void)hipGetLastError();
  }
  if (grid_blocks < 0) return;
  Params p{};
  for (int i = 0; i < 28; ++i) p.in[i] = (const float*)d_in[i];
  p.out = (float*)d_out;
  p.ws = (char*)d_ws;
  p.ph_lo = 0;
  p.ph_hi = NPHASES;
  (void)hipMemsetAsync((char*)d_ws + OFF_BAR, 0, 16384, stream);
  void* args[] = {&p};
  hipError_t e = hipLaunchCooperativeKernel((const void*)fwd_megakernel, dim3(grid_blocks), dim3(NTHR), args, LDS_BYTES, stream);
  if (e != hipSuccess) fprintf(stderr, "cooperative launch failed: %s (grid %d)\n", hipGetErrorString(e), grid_blocks);
}
```

```cpp
#include <hip/hip_runtime.h>
#include <hip/hip_cooperative_groups.h>
#include <cstdio>
#include <cstdint>
namespace cg = cooperative_groups;

typedef unsigned short bf16_t;
typedef __attribute__((ext_vector_type(8))) short bf16x8;
typedef __attribute__((ext_vector_type(4))) float f32x4;
typedef __attribute__((ext_vector_type(16))) float f32x16;
typedef __attribute__((ext_vector_type(4))) unsigned u32x4;
typedef __attribute__((ext_vector_type(2))) float f32x2;

#define NTHR 512
#ifndef PROBE_MASK
#define PROBE_MASK 0
#endif
constexpr int D = 1024, FF = 2816, NGU = 5632, SEQ = 8192, CTXL = 256, MLAT = 16384, MALL = 16896, NKEY = 8448;
constexpr float EPSN = 1e-6f;

constexpr size_t OFF_BAR = 0;
constexpr size_t OFF_MOD = 16384;
constexpr size_t OFF_HID3 = OFF_MOD + 442368;
constexpr size_t OFF_HID3C = OFF_HID3 + 2097152;
constexpr size_t OFF_WOUTT = OFF_HID3C + 131072;
constexpr size_t OFF_WGU = OFF_WOUTT + 1048576;
constexpr size_t OFF_WD = OFF_WGU + 92274688;
constexpr size_t OFF_WQKV = OFF_WD + 46137344;
constexpr size_t OFF_WO = OFF_WQKV + 6291456;
constexpr size_t OFF_WIN = OFF_WO + 4194304;
constexpr size_t OFF_WHO = OFF_WIN + 12582912;
constexpr size_t OFF_S = OFF_WHO + 4194304;
constexpr size_t OFF_HB = OFF_S + 69206016;
constexpr size_t OFF_ACT = OFF_HB + 34603008;
constexpr size_t OFF_Q = OFF_ACT + 95158272;
constexpr size_t OFF_KB = OFF_Q + 34603008;
constexpr size_t OFF_VT = OFF_KB + 8650752;
constexpr size_t OFF_OB = OFF_VT + 8650752;
constexpr size_t OFF_FILT = OFF_OB + 34603008;
constexpr size_t OFF_XS = OFF_FILT + 67108864;
constexpr size_t OFF_PART = OFF_XS + (size_t)512 * 65536;
constexpr size_t OFF_YT = OFF_PART + (size_t)11 * 512 * 1024 * 4;
constexpr size_t WS_END = OFF_YT + (size_t)1024 * 16896 * 2;

struct Params {
  const float* in[28];
  float* out;
  char* ws;
  int ph_lo, ph_hi;
};

__device__ __forceinline__ int tid_() { int t = threadIdx.x; asm volatile("" : "+v"(t)); return t; }
__device__ __forceinline__ bf16_t f2bf(float f) {
  unsigned u = __float_as_uint(f);
  u += 0x7fffu + ((u >> 16) & 1u);
  return (bf16_t)(u >> 16);
}
__device__ __forceinline__ float bf2f(bf16_t h) { return __uint_as_float(((unsigned)h) << 16); }

__device__ __forceinline__ unsigned cvt_pk_bf16(float lo, float hi) { unsigned r; asm volatile("v_cvt_pk_bf16_f32 %0, %1, %2" : "=v"(r) : "v"(lo), "v"(hi)); return r; }
__device__ __forceinline__ unsigned pack2(float a, float b) { return cvt_pk_bf16(a, b); }
__device__ __forceinline__ float silu_f(float x) { return x * __builtin_amdgcn_rcpf(1.f + __expf(-x)); }
__device__ __forceinline__ int swz(int row, int ch) { return row * 128 + ((ch ^ ((row >> 1) & 7)) << 4); }
__device__ __forceinline__ float2 cmul(float2 a, float2 b) { return make_float2(a.x * b.x - a.y * b.y, a.x * b.y + a.y * b.x); }
__device__ __forceinline__ float2 cexp_rev(float rev) { return make_float2(__builtin_amdgcn_cosf(rev), __builtin_amdgcn_sinf(rev)); }

enum { EPI_SWIGLU = 0, EPI_RESID = 1, EPI_QK = 2, EPI_T = 3, EPI_FILT = 4 };

struct Epi {
  float* S; const float* Sin; float* out2; const float* gate; const float* bias; float coef;
  bf16_t* ob; int ldo; int vmode; int atomic; float* part;
  bf16_t* q; bf16_t* kb; const float* qn; const float* kn;
};

__device__ __forceinline__ int swz32(int row, int ch) { return row * 64 + ((ch ^ ((0 - (row >> 2)) & 3)) << 4); }

template <int EPI>
__device__ __forceinline__ void gemm256_tile(const bf16_t* A, const bf16_t* Bt, int ld, int kt0, int nkt, int m0, int n0, char* lds, const Epi& e, int part) {
  const int tid = tid_(), lane = tid & 63, w = __builtin_amdgcn_readfirstlane(tid >> 6);
  const int wm = w >> 2, wn = w & 3;
  const int fr = lane & 15, fq = lane >> 4;
  f32x4 acc[8][4];
#pragma unroll
  for (int i = 0; i < 8; ++i)
#pragma unroll
    for (int j = 0; j < 4; ++j) acc[i][j] = (f32x4){0.f, 0.f, 0.f, 0.f};
  unsigned soff[2];
#pragma unroll
  for (int i = 0; i < 2; ++i) {
    const int r = 16 * (w * 2 + i) + (lane >> 2);
    const int c = (lane & 3) ^ ((0 - (r >> 2)) & 3);
    soff[i] = (unsigned)(r * ld + c * 8);
  }
  const int nks = nkt * 2;
  const bf16_t* Ab = A + (size_t)m0 * ld + (size_t)kt0 * 64;
  const bf16_t* Bb = Bt + (size_t)n0 * ld + (size_t)kt0 * 64;
  char* ldsw = lds + w * 2048;
#define G256_ISSUE(step)                                                                                                        \
  do {                                                                                                                          \
    const int st_ = (step) < nks ? (step) : (nks - 1);                                                                          \
    char* dA_ = ldsw + ((step) & 3) * 32768;                                                                                    \
    const bf16_t* ga_ = Ab + (size_t)st_ * 32;                                                                                  \
    const bf16_t* gb_ = Bb + (size_t)st_ * 32;                                                                                  \
    __builtin_amdgcn_global_load_lds((const unsigned*)(ga_ + soff[0]), (unsigned*)(dA_), 16, 0, 0);                             \
    __builtin_amdgcn_global_load_lds((const unsigned*)(ga_ + soff[1]), (unsigned*)(dA_ + 1024), 16, 0, 0);                      \
    __builtin_amdgcn_global_load_lds((const unsigned*)(gb_ + soff[0]), (unsigned*)(dA_ + 16384), 16, 0, 0);                     \
    __builtin_amdgcn_global_load_lds((const unsigned*)(gb_ + soff[1]), (unsigned*)(dA_ + 16384 + 1024), 16, 0, 0);              \
  } while (0)
  G256_ISSUE(0);
  G256_ISSUE(1);
  G256_ISSUE(2);
  for (int t = 0; t < nks; ++t) {
    asm volatile("s_waitcnt vmcnt(8) lgkmcnt(0)" ::: "memory");
    __builtin_amdgcn_s_barrier();
    asm volatile("" ::: "memory");
    G256_ISSUE(t + 3);
    const char* cA = lds + (t & 3) * 32768;
    const char* cB = cA + 16384;
    bf16x8 bfr[4];
#pragma unroll
    for (int ni = 0; ni < 4; ++ni) bfr[ni] = *(const bf16x8*)(cB + swz32(wn * 64 + ni * 16 + fr, fq));
#pragma unroll
    for (int mh = 0; mh < 2; ++mh) {
      bf16x8 af[4];
#pragma unroll
      for (int mi = 0; mi < 4; ++mi) af[mi] = *(const bf16x8*)(cA + swz32(wm * 128 + (mh * 4 + mi) * 16 + fr, fq));
#pragma unroll
      for (int mi = 0; mi < 4; ++mi)
#pragma unroll
        for (int ni = 0; ni < 4; ++ni)
          acc[mh * 4 + mi][ni] = __builtin_amdgcn_mfma_f32_16x16x32_bf16(bfr[ni], af[mi], acc[mh * 4 + mi][ni], 0, 0, 0);
    }
  }
  asm volatile("s_waitcnt vmcnt(0)" ::: "memory");
  __syncthreads();
#undef G256_ISSUE
  const int rbase = m0 + wm * 128 + fr;
  const int cbase = n0 + wn * 64 + 4 * fq;
  if (EPI == EPI_SWIGLU) {
#pragma unroll
    for (int mi = 0; mi < 8; ++mi) {
      const int rl = wm * 128 + mi * 16 + fr;
#pragma unroll
      for (int nj = 0; nj < 2; ++nj) {
        const int fl = wn * 32 + nj * 16 + 4 * fq;
        const f32x4 g = acc[mi][2 * nj], u = acc[mi][2 * nj + 1];
        uint2 pk;
        pk.x = pack2(silu_f(g[0]) * u[0], silu_f(g[1]) * u[1]);
        pk.y = pack2(silu_f(g[2]) * u[2], silu_f(g[3]) * u[3]);
        *(uint2*)(lds + rl * 272 + fl * 2) = pk;
      }
    }
    __syncthreads();
    {
      bf16_t* dst = e.ob + (size_t)m0 * FF + (n0 >> 1);
#pragma unroll
      for (int i = 0; i < 8; ++i) {
        const int c = tid + 512 * i;
        const int rl = c >> 4, ch = c & 15;
        const uint4 v = *(const uint4*)(lds + rl * 272 + ch * 16);
        *(uint4*)(dst + (size_t)rl * FF + ch * 8) = v;
      }
    }
    __syncthreads();
  } else if (EPI == EPI_RESID) {
    const int grp = (m0 < SEQ) ? 0 : ((m0 < MLAT) ? 1 : 2);
#pragma unroll
    for (int ni = 0; ni < 4; ++ni) {
      const int col = cbase + ni * 16;
      float4 g = *(const float4*)(e.gate + grp * 9216 + col);
      g.x *= e.coef; g.y *= e.coef; g.z *= e.coef; g.w *= e.coef;
      float4 bv = make_float4(0.f, 0.f, 0.f, 0.f);
      if (e.bias && part == 0) bv = *(const float4*)(e.bias + col);
#pragma unroll
      for (int mi = 0; mi < 8; ++mi) {
        const int row = rbase + mi * 16;
        const size_t idx = (size_t)row * D + col;
        const f32x4 a = acc[mi][ni];
        if (e.atomic) {
          float4 o4;
          o4.x = g.x * (a[0] + bv.x); o4.y = g.y * (a[1] + bv.y); o4.z = g.z * (a[2] + bv.z); o4.w = g.w * (a[3] + bv.w);
          *(float4*)(e.part + ((size_t)part * 512 + (row - MLAT)) * D + col) = o4;
        } else {
          float4 s4 = *(const float4*)(e.Sin + idx);
          s4.x += g.x * (a[0] + bv.x); s4.y += g.y * (a[1] + bv.y); s4.z += g.z * (a[2] + bv.z); s4.w += g.w * (a[3] + bv.w);
          *(float4*)(e.S + idx) = s4;
          if (e.out2 && row < MLAT) *(float4*)(e.out2 + idx) = s4;
        }
      }
    }
  } else if (EPI == EPI_QK) {
    const int hcol0 = n0 + wn * 64;
    const bool isq = hcol0 < 1024;
    const float* nw = isq ? e.qn : e.kn;
    float4 nwv[4];
#pragma unroll
    for (int ni = 0; ni < 4; ++ni) nwv[ni] = *(const float4*)(nw + ni * 16 + 4 * fq);
    float freq[4];
#pragma unroll
    for (int i = 0; i < 4; ++i) freq[i] = exp2f(-(float)(4 * fq + i) * (13.287712379549449f / 16.f)) * 0.15915494309189535f;
    const float qs = isq ? (0.125f * 1.4426950408889634f) : 1.f;
#pragma unroll
    for (int mi = 0; mi < 8; ++mi) {
      const int row = rbase + mi * 16;
      f32x4 v[4];
      float ss = 0.f;
#pragma unroll
      for (int ni = 0; ni < 4; ++ni) { v[ni] = acc[mi][ni]; ss += v[ni][0] * v[ni][0] + v[ni][1] * v[ni][1] + v[ni][2] * v[ni][2] + v[ni][3] * v[ni][3]; }
      ss += __shfl_xor(ss, 16); ss += __shfl_xor(ss, 32);
      const float rstd = rsqrtf(ss * (1.f / 64.f) + EPSN);
#pragma unroll
      for (int ni = 0; ni < 4; ++ni) {
        v[ni][0] *= rstd * nwv[ni].x; v[ni][1] *= rstd * nwv[ni].y; v[ni][2] *= rstd * nwv[ni].z; v[ni][3] *= rstd * nwv[ni].w;
      }
      if (row < MLAT) {
        const int t = row & (SEQ - 1);
        const float pr = (float)(t >> 6), pc = (float)(t & 63);
#pragma unroll
        for (int i = 0; i < 4; ++i) {
          const float ar = pr * freq[i], ac = pc * freq[i];
          const float cr = __builtin_amdgcn_cosf(ar), sr = __builtin_amdgcn_sinf(ar);
          const float cc = __builtin_amdgcn_cosf(ac), sc = __builtin_amdgcn_sinf(ac);
          const float a0 = v[0][i] * cr - v[1][i] * sr, a1 = v[0][i] * sr + v[1][i] * cr;
          const float a2 = v[2][i] * cc - v[3][i] * sc, a3 = v[2][i] * sc + v[3][i] * cc;
          v[0][i] = a0; v[1][i] = a1; v[2][i] = a2; v[3][i] = a3;
        }
      }
      bf16_t* dst;
      if (isq) dst = e.q + (size_t)row * D + hcol0 + 4 * fq;
      else {
        const int kvh = (hcol0 - 1024) >> 6;
        int b, pos;
        if (row < MLAT) { b = row >> 13; pos = CTXL + (row & (SEQ - 1)); }
        else { b = (row - MLAT) >> 8; pos = (row - MLAT) & 255; }
        dst = e.kb + ((size_t)(b * 4 + kvh) * NKEY + pos) * 64 + 4 * fq;
      }
#pragma unroll
      for (int ni = 0; ni < 4; ++ni) {
        uint2 pk;
        pk.x = pack2(v[ni][0] * qs, v[ni][1] * qs);
        pk.y = pack2(v[ni][2] * qs, v[ni][3] * qs);
        *(uint2*)(dst + ni * 16) = pk;
      }
    }
  } else if (EPI == EPI_T) {
#pragma unroll
    for (int ni = 0; ni < 4; ++ni) {
      const int tok = cbase + ni * 16;
      size_t cm = (size_t)tok;
      if (e.vmode) {
        int b, pos;
        if (tok < MLAT) { b = tok >> 13; pos = CTXL + (tok & (SEQ - 1)); }
        else { b = (tok - MLAT) >> 8; pos = (tok - MLAT) & 255; }
        cm = (size_t)b * 256 * NKEY + pos;
      }
#pragma unroll
      for (int mi = 0; mi < 8; ++mi) {
        const int row = rbase + mi * 16;
        const float bv = e.bias ? e.bias[row] : 0.f;
        const f32x4 a = acc[mi][ni];
        uint2 pk;
        pk.x = pack2(a[0] + bv, a[1] + bv);
        pk.y = pack2(a[2] + bv, a[3] + bv);
        *(uint2*)(e.ob + (size_t)row * e.ldo + cm) = pk;
      }
    }
  } else if (EPI == EPI_FILT) {
#pragma unroll
    for (int mi = 0; mi < 8; ++mi) {
      const int row = rbase + mi * 16;
      const int d = row & 1023;
      const float delta = fabsf(-3.0701134573253945f + (float)d * ((-15.350567286626973f + 3.0701134573253945f) / 1023.f));
      const float dk = -delta * (1.f / 8191.f);
#pragma unroll
      for (int ni = 0; ni < 4; ++ni) {
        const int t = cbase + ni * 16;
        const f32x4 a = acc[mi][ni];
        uint2 pk;
        pk.x = pack2(a[0] * __expf((float)t * dk), a[1] * __expf((float)(t + 1) * dk));
        pk.y = pack2(a[2] * __expf((float)(t + 2) * dk), a[3] * __expf((float)(t + 3) * dk));
        *(uint2*)(e.ob + (size_t)row * SEQ + t) = pk;
      }
    }
  }
}

template <int EPI>
__device__ __forceinline__ void gemm256_phase(const bf16_t* A, const bf16_t* Bt, int ld, int nkt, int MT, int NTn, char* lds, const Epi& e, int rot) {
  const int G = gridDim.x;
  const int total = MT * NTn;
  int bid = (int)((blockIdx.x + G - (rot % G)) % G);
  if ((G & 7) == 0) bid = (bid & 7) * (G >> 3) + (bid >> 3);
  for (int u = bid; u < total; u += G) {
    const int band = u / (8 * NTn);
    const int rem = u - band * 8 * NTn;
    const int gsz = min(8, MT - band * 8);
    const int nt = rem / gsz, mt = band * 8 + (rem - nt * gsz);
    gemm256_tile<EPI>(A, Bt, ld, 0, nkt, mt * 256, nt * 256, lds, e, 0);
  }
}

__device__ __forceinline__ void convert_matrix(const float* src, int K, int N, bf16_t* dst, int perm, char* lds, int& rot) {
  const int G = gridDim.x, tid = tid_();
  const int tn = N >> 8, tk = K >> 6, total = tn * tk;
  bf16_t* T = (bf16_t*)lds;
  const int kr0 = tid >> 6, c4 = tid & 63;
  int t = (int)((blockIdx.x + G - (rot % G)) % G);
  float4 v[8];
  if (t < total) {
    const int kt = t / tn, ntile = t - kt * tn;
    const float* g = src + (size_t)((kt << 6) + kr0) * N + (ntile << 8) + c4 * 4;
#pragma unroll
    for (int i = 0; i < 8; ++i) v[i] = *(const float4*)(g + (size_t)(8 * i) * N);
  }
  for (; t < total; t += G) {
    const int kt = t / tn, ntile = t - kt * tn;
    const int k0 = kt << 6, n0 = ntile << 8;
#pragma unroll
    for (int i = 0; i < 8; ++i) {
      const int kr = kr0 + 8 * i;
      T[(c4 * 4 + 0) * 72 + kr] = f2bf(v[i].x);
      T[(c4 * 4 + 1) * 72 + kr] = f2bf(v[i].y);
      T[(c4 * 4 + 2) * 72 + kr] = f2bf(v[i].z);
      T[(c4 * 4 + 3) * 72 + kr] = f2bf(v[i].w);
    }
    const int t2 = t + G;
    if (t2 < total) {
      const int kt2 = t2 / tn, nt2 = t2 - kt2 * tn;
      const float* g = src + (size_t)((kt2 << 6) + kr0) * N + (nt2 << 8) + c4 * 4;
#pragma unroll
      for (int i = 0; i < 8; ++i) v[i] = *(const float4*)(g + (size_t)(8 * i) * N);
    }
    __syncthreads();
#pragma unroll
    for (int i = 0; i < 4; ++i) {
      const int idx = tid + 512 * i;
      const int n = idx >> 3, ch = idx & 7;
      const uint4 o = *(const uint4*)(T + n * 72 + ch * 8);
      int ng = n0 + n;
      if (perm) {
        if (ng < FF) ng = ((ng >> 4) << 5) + (ng & 15);
        else { const int f = ng - FF; ng = ((f >> 4) << 5) + 16 + (f & 15); }
      }
      *(uint4*)(dst + (size_t)ng * K + k0 + ch * 8) = o;
    }
    __syncthreads();
  }
  rot += total;
}

__device__ __forceinline__ void p0_prologue(const Params& p, char* lds) {
  const int G = gridDim.x, tid = tid_(), lane = tid & 63, w = tid >> 6;
  char* ws = p.ws;
  {
    float4* S4 = (float4*)(ws + OFF_S);
    const float4* x4 = (const float4*)p.in[0];
    const float4* c4 = (const float4*)p.in[2];
    const size_t nlat = (size_t)MLAT * D / 4, nall = (size_t)MALL * D / 4;
    (void)x4;
    for (size_t i = nlat + (size_t)blockIdx.x * NTHR + tid; i < nall; i += (size_t)G * NTHR)
      S4[i] = c4[i - nlat];
  }
  {
    float* MOD = (float*)(ws + OFF_MOD);
    const float* c = p.in[1];
    const float* cc = p.in[3];
    float* red = (float*)lds;
    for (int it = blockIdx.x; it < 4 * 144; it += G) {
      const int l = it / 144, c0 = (it - l * 144) * 64;
      const int cg4 = lane & 15, kq = lane >> 4;
      float a[3][4];
#pragma unroll
      for (int g = 0; g < 3; ++g)
#pragma unroll
        for (int j = 0; j < 4; ++j) a[g][j] = 0.f;
      const float* wb = p.in[4] + (size_t)l * D * 9216 + c0 + cg4 * 4;
#pragma unroll 4
      for (int i = 0; i < 32; ++i) {
        const int k = w * 128 + i * 4 + kq;
        const float4 wv = *(const float4*)(wb + (size_t)k * 9216);
        const float s0 = silu_f(c[k]), s1 = silu_f(c[D + k]), s2 = silu_f(cc[k]);
        a[0][0] += s0 * wv.x; a[0][1] += s0 * wv.y; a[0][2] += s0 * wv.z; a[0][3] += s0 * wv.w;
        a[1][0] += s1 * wv.x; a[1][1] += s1 * wv.y; a[1][2] += s1 * wv.z; a[1][3] += s1 * wv.w;
        a[2][0] += s2 * wv.x; a[2][1] += s2 * wv.y; a[2][2] += s2 * wv.z; a[2][3] += s2 * wv.w;
      }
#pragma unroll
      for (int g = 0; g < 3; ++g)
#pragma unroll
        for (int j = 0; j < 4; ++j) {
          float v = a[g][j];
          v += __shfl_xor(v, 16); v += __shfl_xor(v, 32);
          a[g][j] = v;
        }
      if (kq == 0) {
#pragma unroll
        for (int g = 0; g < 3; ++g)
#pragma unroll
          for (int j = 0; j < 4; ++j) red[(w * 3 + g) * 64 + cg4 * 4 + j] = a[g][j];
      }
      __syncthreads();
      if (tid < 192) {
        const int g = tid >> 6, col = tid & 63;
        float s = 0.f;
#pragma unroll
        for (int ww = 0; ww < 8; ++ww) s += red[(ww * 3 + g) * 64 + col];
        MOD[(size_t)(l * 3 + g) * 9216 + c0 + col] = s + p.in[5][(size_t)l * 9216 + c0 + col];
      }
      __syncthreads();
    }
  }
  {
    int rot = 0;
    for (int i = 0; i < 8; ++i) convert_matrix(p.in[7] + (size_t)i * D * NGU, D, NGU, (bf16_t*)(ws + OFF_WGU) + (size_t)i * NGU * D, 1, lds, rot);
    for (int i = 0; i < 8; ++i) convert_matrix(p.in[8] + (size_t)i * FF * D, FF, D, (bf16_t*)(ws + OFF_WD) + (size_t)i * D * FF, 0, lds, rot);
    for (int i = 0; i < 2; ++i) convert_matrix(p.in[9] + (size_t)i * D * 1536, D, 1536, (bf16_t*)(ws + OFF_WQKV) + (size_t)i * 1536 * D, 0, lds, rot);
    for (int i = 0; i < 2; ++i) convert_matrix(p.in[10] + (size_t)i * D * D, D, D, (bf16_t*)(ws + OFF_WO) + (size_t)i * D * D, 0, lds, rot);
    for (int i = 0; i < 2; ++i) convert_matrix(p.in[13] + (size_t)i * D * 3072, D, 3072, (bf16_t*)(ws + OFF_WIN) + (size_t)i * 3072 * D, 0, lds, rot);
    for (int i = 0; i < 2; ++i) convert_matrix(p.in[26] + (size_t)i * D * D, D, D, (bf16_t*)(ws + OFF_WHO) + (size_t)i * D * D, 0, lds, rot);
    for (int i = 0; i < 2; ++i) convert_matrix(p.in[23] + (size_t)i * 64 * 4096, 64, 4096, (bf16_t*)(ws + OFF_WOUTT) + (size_t)i * 4096 * 64, 0, lds, rot);
  }
  {
    float* W1 = (float*)lds;
    float* W2 = W1 + 33 * 64;
    float* W3 = W2 + 64 * 64;
    float* feat = W3 + 64 * 64;
    float* h1 = feat + 8 * 40;
    float* h2 = h1 + 8 * 64;
    const int tt = tid >> 6, h = tid & 63;
    const int per = 256 + 8;
    int jcur = -1;
    for (int it = blockIdx.x; it < 2 * per; it += G) {
      const int j = it / per;
      int r = it - j * per;
      const int Lsel = (r >= 256);
      if (Lsel) r -= 256;
      const int L = Lsel ? 256 : 8192;
      if (j != jcur) {
        __syncthreads();
        for (int i = tid; i < 33 * 64; i += NTHR) W1[i] = p.in[17][(size_t)j * 33 * 64 + i];
        for (int i = tid; i < 64 * 64; i += NTHR) { W2[i] = p.in[19][(size_t)j * 4096 + i]; W3[i] = p.in[21][(size_t)j * 4096 + i]; }
        jcur = j;
        __syncthreads();
      }
      const float a = p.in[24][j * 64 + h];
      const float b1 = p.in[18][j * 64 + h], b2 = p.in[20][j * 64 + h], b3 = p.in[22][j * 64 + h];
      for (int sub = 0; sub < 4; ++sub) {
        const int t = r * 32 + sub * 8 + tt;
        if (h < 33) {
          const float tl = (float)t / (float)(L - 1);
          const float wv = (6.2831855f * (float)t) / (float)L;
          float f;
          if (h == 0) f = tl;
          else {
            const int bi = (h - 1) & 15;
            const float band = 1e-4f + (float)bi * ((15.f - 1e-4f) / 15.f);
            const float ang = band * wv;
            f = (h <= 16) ? __cosf(ang) : -__sinf(ang);
          }
          feat[tt * 40 + h] = f;
        }
        __syncthreads();
        {
          float s = b1;
#pragma unroll
          for (int e2 = 0; e2 < 33; ++e2) s += feat[tt * 40 + e2] * W1[e2 * 64 + h];
          h1[tt * 64 + h] = __sinf(a * s);
        }
        __syncthreads();
        {
          float s = b2;
#pragma unroll 16
          for (int k = 0; k < 64; ++k) s += h1[tt * 64 + k] * W2[k * 64 + h];
          h2[tt * 64 + h] = __sinf(a * s);
        }
        __syncthreads();
        {
          float s = b3;
#pragma unroll 16
          for (int k = 0; k < 64; ++k) s += h2[tt * 64 + k] * W3[k * 64 + h];
          const float v = __sinf(a * s);
          if (Lsel) ((float*)(ws + OFF_HID3C))[((size_t)j * 256 + t) * 64 + h] = v;
          else ((bf16_t*)(ws + OFF_HID3))[((size_t)j * 8192 + t) * 64 + h] = f2bf(v);
        }
      }
    }
    __syncthreads();
  }
}

__device__ __forceinline__ void normmod_phase(const Params& p, int l, int k, int rows, int nparts) {
  const int G = gridDim.x, tid = tid_(), lane = tid & 63, w = tid >> 6;
  float* S = (float*)(p.ws + OFF_S);
  const float* PART = (const float*)(p.ws + OFF_PART);
  bf16_t* HB = (bf16_t*)(p.ws + OFF_HB);
  const float* MOD = (const float*)(p.ws + OFF_MOD) + (size_t)l * 3 * 9216;
  const float* nw = p.in[6] + (size_t)(l * 3 + k) * D;
  const int stride = G * 8;
  for (int row0 = blockIdx.x * 8 + w; row0 < rows; row0 += 2 * stride) {
    float4 x[2][4];
    float ss[2] = {0.f, 0.f};
#pragma unroll
    for (int rr = 0; rr < 2; ++rr) {
      const int row = row0 + rr * stride;
      if (row < rows) {
#pragma unroll
        for (int q = 0; q < 4; ++q) x[rr][q] = *(const float4*)(((l == 0 && k == 0 && row < MLAT) ? p.in[0] : (const float*)S) + (size_t)row * D + q * 256 + lane * 4);
      } else {
#pragma unroll
        for (int q = 0; q < 4; ++q) x[rr][q] = make_float4(0.f, 0.f, 0.f, 0.f);
      }
    }
#pragma unroll
    for (int rr = 0; rr < 2; ++rr) {
      const int row = row0 + rr * stride;
      if (row < rows && row >= MLAT && nparts > 0) {
#pragma unroll
        for (int q = 0; q < 4; ++q) {
          for (int pp = 0; pp < nparts; ++pp) {
            const float4 t4 = *(const float4*)(PART + ((size_t)pp * 512 + (row - MLAT)) * D + q * 256 + lane * 4);
            x[rr][q].x += t4.x; x[rr][q].y += t4.y; x[rr][q].z += t4.z; x[rr][q].w += t4.w;
          }
          *(float4*)(S + (size_t)row * D + q * 256 + lane * 4) = x[rr][q];
        }
      }
#pragma unroll
      for (int q = 0; q < 4; ++q) ss[rr] += x[rr][q].x * x[rr][q].x + x[rr][q].y * x[rr][q].y + x[rr][q].z * x[rr][q].z + x[rr][q].w * x[rr][q].w;
    }
#pragma unroll
    for (int o = 1; o < 64; o <<= 1) { ss[0] += __shfl_xor(ss[0], o); ss[1] += __shfl_xor(ss[1], o); }
#pragma unroll
    for (int rr = 0; rr < 2; ++rr) {
      const int row = row0 + rr * stride;
      if (row < rows) {
        const int grp = (row < SEQ) ? 0 : ((row < MLAT) ? 1 : 2);
        const float* sh = MOD + grp * 9216 + (3 * k) * D;
        const float* sc = sh + D;
        const float rstd = rsqrtf(ss[rr] * (1.f / 1024.f) + EPSN);
#pragma unroll
        for (int q = 0; q < 4; ++q) {
          const int c = q * 256 + lane * 4;
          const float4 g = *(const float4*)(nw + c);
          const float4 s1 = *(const float4*)(sc + c);
          const float4 s0 = *(const float4*)(sh + c);
          uint2 pk;
          pk.x = pack2(x[rr][q].x * rstd * g.x * (1.f + s1.x) + s0.x, x[rr][q].y * rstd * g.y * (1.f + s1.y) + s0.y);
          pk.y = pack2(x[rr][q].z * rstd * g.z * (1.f + s1.z) + s0.z, x[rr][q].w * rstd * g.w * (1.f + s1.w) + s0.w);
          *(uint2*)(HB + (size_t)row * D + c) = pk;
        }
      }
    }
  }
}

__device__ __forceinline__ void attention_phase(const Params& p, int ai, char* lds) {
  const int G = gridDim.x, tid = tid_(), lane = tid & 63, w = tid >> 6;
  const int l31 = lane & 31, hh = lane >> 5;
  const bf16_t* Q = (const bf16_t*)(p.ws + OFF_Q);
  const bf16_t* KB = (const bf16_t*)(p.ws + OFF_KB);
  const bf16_t* VT = (const bf16_t*)(p.ws + OFF_VT);
  bf16_t* OB = (bf16_t*)(p.ws + OFF_OB);
  const int lrow = tid >> 3, lch = tid & 7;
  float sbound;
  {
    float mq = fabsf(p.in[11][ai * 64 + lane]), mk = fabsf(p.in[12][ai * 64 + lane]);
#pragma unroll
    for (int o = 1; o < 64; o <<= 1) { mq = fmaxf(mq, __shfl_xor(mq, o)); mk = fmaxf(mk, __shfl_xor(mk, o)); }
    sbound = fminf(8.f * mq * mk * 1.4426950408889634f, 100.f);
  }
  for (int it = blockIdx.x; it < 1024 + 32; it += G) {
    int b, head, rowbase, nT;
    if (it < 1024) { b = it >> 9; head = (it >> 5) & 15; rowbase = b * SEQ + (it & 31) * 256; nT = NKEY / 64; }
    else { const int r = it - 1024; b = r >> 4; head = r & 15; rowbase = MLAT + b * CTXL; nT = CTXL / 64; }
    const int kvh = head >> 2;
    const bf16_t* kp = KB + ((size_t)(b * 4 + kvh) * NKEY + lrow) * 64 + lch * 8;
    const bf16_t* vp = VT + ((size_t)(b * 4 + kvh) * 64 + lrow) * NKEY + lch * 8;
    bf16x8 qf[4];
    {
      const bf16_t* qp = Q + (size_t)(rowbase + w * 32 + l31) * D + head * 64 + hh * 8;
#pragma unroll
      for (int ks = 0; ks < 4; ++ks) qf[ks] = *(const bf16x8*)(qp + ks * 16);
    }
    f32x16 o0, o1;
#pragma unroll
    for (int i = 0; i < 16; ++i) { o0[i] = 0.f; o1[i] = 0.f; }
    f32x16 negm;
#pragma unroll
    for (int i = 0; i < 16; ++i) negm[i] = -sbound;
    float lsa = 0.f, lsb = 0.f;
    uint4 rk = *(const uint4*)(kp);
    uint4 rv = *(const uint4*)(vp);
    *(uint4*)(lds + swz(lrow, lch)) = rk;
    *(uint2*)(lds + 16384 + lrow * 136 + lch * 16) = make_uint2(rv.x, rv.y);
    *(uint2*)(lds + 16384 + lrow * 136 + lch * 16 + 8) = make_uint2(rv.z, rv.w);
    __syncthreads();
    for (int kt = 0; kt < nT; ++kt) {
      char* cK = lds + (kt & 1) * 8192;
      char* cV = lds + 16384 + (kt & 1) * 8704;
      const bool more = (kt + 1 < nT);
      if (more) {
        rk = *(const uint4*)(kp + (size_t)(kt + 1) * 64 * 64);
        rv = *(const uint4*)(vp + (kt + 1) * 64);
      }
      f32x16 s0, s1;
      {
        const bf16x8 a0 = *(const bf16x8*)(cK + swz(l31, hh));
        const bf16x8 a1 = *(const bf16x8*)(cK + swz(l31 + 32, hh));
        s0 = __builtin_amdgcn_mfma_f32_32x32x16_bf16(a0, qf[0], negm, 0, 0, 0);
        s1 = __builtin_amdgcn_mfma_f32_32x32x16_bf16(a1, qf[0], negm, 0, 0, 0);
      }
#pragma unroll
      for (int ks = 1; ks < 4; ++ks) {
        const bf16x8 a0 = *(const bf16x8*)(cK + swz(l31, 2 * ks + hh));
        const bf16x8 a1 = *(const bf16x8*)(cK + swz(l31 + 32, 2 * ks + hh));
        s0 = __builtin_amdgcn_mfma_f32_32x32x16_bf16(a0, qf[ks], s0, 0, 0, 0);
        s1 = __builtin_amdgcn_mfma_f32_32x32x16_bf16(a1, qf[ks], s1, 0, 0, 0);
      }
#pragma unroll
      for (int i = 0; i < 16; i += 2) {
        s0[i] = __builtin_amdgcn_exp2f(s0[i]); s0[i + 1] = __builtin_amdgcn_exp2f(s0[i + 1]);
        s1[i] = __builtin_amdgcn_exp2f(s1[i]); s1[i + 1] = __builtin_amdgcn_exp2f(s1[i + 1]);
        lsa += s0[i] + s1[i];
        lsb += s0[i + 1] + s1[i + 1];
      }
      bf16x8 pf[4];
#pragma unroll
      for (int j = 0; j < 4; ++j) {
        u32x4 cv;
#pragma unroll
        for (int q2 = 0; q2 < 4; ++q2) {
          const int i0 = 8 * (j & 1) + 2 * q2;
          const float x0 = (j < 2) ? s0[i0] : s1[i0];
          const float x1 = (j < 2) ? s0[i0 + 1] : s1[i0 + 1];
          cv[q2] = cvt_pk_bf16(x0, x1);
        }
        pf[j] = __builtin_bit_cast(bf16x8, cv);
      }
#pragma unroll
      for (int j = 0; j < 4; ++j) {
        const char* r0 = cV + l31 * 136 + j * 32 + hh * 8;
        const char* r1 = cV + (l31 + 32) * 136 + j * 32 + hh * 8;
        const uint2 x0 = *(const uint2*)(r0), x1 = *(const uint2*)(r0 + 16);
        const uint2 y0 = *(const uint2*)(r1), y1 = *(const uint2*)(r1 + 16);
        const u32x4 v0 = {x0.x, x0.y, x1.x, x1.y};
        const u32x4 v1 = {y0.x, y0.y, y1.x, y1.y};
        o0 = __builtin_amdgcn_mfma_f32_32x32x16_bf16(__builtin_bit_cast(bf16x8, v0), pf[j], o0, 0, 0, 0);
        o1 = __builtin_amdgcn_mfma_f32_32x32x16_bf16(__builtin_bit_cast(bf16x8, v1), pf[j], o1, 0, 0, 0);
      }
      if (more) {
        char* nK = lds + ((kt + 1) & 1) * 8192;
        char* nV = lds + 16384 + ((kt + 1) & 1) * 8704;
        *(uint4*)(nK + swz(lrow, lch)) = rk;
        *(uint2*)(nV + lrow * 136 + lch * 16) = make_uint2(rv.x, rv.y);
        *(uint2*)(nV + lrow * 136 + lch * 16 + 8) = make_uint2(rv.z, rv.w);
      }
      __syncthreads();
    }
    float lsum = lsa + lsb;
    lsum += __shfl_xor(lsum, 32);
    const float inv = 1.f / lsum;
    bf16_t* op = OB + (size_t)(rowbase + w * 32 + l31) * D + head * 64 + hh * 4;
#pragma unroll
    for (int g4 = 0; g4 < 4; ++g4) {
      uint2 pk;
      pk.x = pack2(o0[g4 * 4 + 0] * inv, o0[g4 * 4 + 1] * inv);
      pk.y = pack2(o0[g4 * 4 + 2] * inv, o0[g4 * 4 + 3] * inv);
      *(uint2*)(op + g4 * 8) = pk;
      pk.x = pack2(o1[g4 * 4 + 0] * inv, o1[g4 * 4 + 1] * inv);
      pk.y = pack2(o1[g4 * 4 + 2] * inv, o1[g4 * 4 + 3] * inv);
      *(uint2*)(op + 32 + g4 * 8) = pk;
    }
  }
}

__device__ __forceinline__ void dft16(float2 (&v)[16]) {
  float2 t[4][4];
#pragma unroll
  for (int a = 0; a < 4; ++a) {
    const float2 x0 = v[a], x1 = v[a + 4], x2 = v[a + 8], x3 = v[a + 12];
    const float2 s0 = make_float2(x0.x + x2.x, x0.y + x2.y), s1 = make_float2(x0.x - x2.x, x0.y - x2.y);
    const float2 s2 = make_float2(x1.x + x3.x, x1.y + x3.y), s3 = make_float2(x1.x - x3.x, x1.y - x3.y);
    t[a][0] = make_float2(s0.x + s2.x, s0.y + s2.y);
    t[a][1] = make_float2(s1.x + s3.y, s1.y - s3.x);
    t[a][2] = make_float2(s0.x - s2.x, s0.y - s2.y);
    t[a][3] = make_float2(s1.x - s3.y, s1.y + s3.x);
  }
  const float C1 = 0.92387953251128674f, S1 = 0.38268343236508977f, R2 = 0.70710678118654752f;
  t[1][1] = cmul(t[1][1], make_float2(C1, -S1));
  t[1][2] = cmul(t[1][2], make_float2(R2, -R2));
  t[1][3] = cmul(t[1][3], make_float2(S1, -C1));
  t[2][1] = cmul(t[2][1], make_float2(R2, -R2));
  t[2][2] = make_float2(t[2][2].y, -t[2][2].x);
  t[2][3] = cmul(t[2][3], make_float2(-R2, -R2));
  t[3][1] = cmul(t[3][1], make_float2(S1, -C1));
  t[3][2] = cmul(t[3][2], make_float2(-R2, -R2));
  t[3][3] = cmul(t[3][3], make_float2(-C1, S1));
#pragma unroll
  for (int c = 0; c < 4; ++c) {
    const float2 x0 = t[0][c], x1 = t[1][c], x2 = t[2][c], x3 = t[3][c];
    const float2 s0 = make_float2(x0.x + x2.x, x0.y + x2.y), s1 = make_float2(x0.x - x2.x, x0.y - x2.y);
    const float2 s2 = make_float2(x1.x + x3.x, x1.y + x3.y), s3 = make_float2(x1.x - x3.x, x1.y - x3.y);
    v[c] = make_float2(s0.x + s2.x, s0.y + s2.y);
    v[c + 4] = make_float2(s1.x + s3.y, s1.y - s3.x);
    v[c + 8] = make_float2(s0.x - s2.x, s0.y - s2.y);
    v[c + 12] = make_float2(s1.x - s3.y, s1.y + s3.x);
  }
}

__device__ __forceinline__ void r16_pass(float2 (&r)[16], float2* buf, int tid, int Ns) {
  const int k = tid & (Ns - 1);
  if (Ns > 1) {
    const float2 w1 = cexp_rev(-(float)k / (float)(16 * Ns));
    float2 w = w1;
#pragma unroll
    for (int i = 1; i < 16; ++i) {
      r[i] = cmul(r[i], w);
      w = cmul(w, w1);
    }
  }
  dft16(r);
  const int j0 = ((tid - k) << 4) + k;
#pragma unroll
  for (int m = 0; m < 16; ++m) { const int ix = j0 + m * Ns; buf[ix + (ix >> 4)] = r[m]; }
}

__device__ __forceinline__ void fft8192(float2 (&r)[16], float2* buf, int tid) {
#pragma unroll
  for (int Ns = 1; Ns < 4096; Ns <<= 4) {
    r16_pass(r, buf, tid, Ns);
    __syncthreads();
#pragma unroll
    for (int i = 0; i < 16; ++i) { const int ix = tid + 512 * i; r[i] = buf[ix + (ix >> 4)]; }
    __syncthreads();
  }
#pragma unroll
  for (int b = 0; b < 8; ++b) {
    const int j = tid + 512 * b;
    const float2 a0 = r[b];
    const float2 a1 = cmul(r[b + 8], cexp_rev(-(float)j * (1.f / 8192.f)));
    r[b] = make_float2(a0.x + a1.x, a0.y + a1.y);
    r[b + 8] = make_float2(a0.x - a1.x, a0.y - a1.y);
  }
}

__device__ __forceinline__ void stage_rows(const bf16_t* r0, const bf16_t* r1, char* dst, int tid) {
#pragma unroll
  for (int i = 0; i < 4; ++i) {
    const int c = tid + 512 * i;
    const bf16_t* src = (c < 1024) ? (r0 + c * 8) : (r1 + (c - 1024) * 8);
    *(uint4*)(dst + c * 16) = *(const uint4*)src;
  }
}

__device__ __forceinline__ void hyena_conv_phase(const Params& p, int j, bool with_ctx, char* lds) {
  const int G = gridDim.x, tid = tid_();
  const bf16_t* U = (const bf16_t*)(p.ws + OFF_ACT);
  const bf16_t* FILT = (const bf16_t*)(p.ws + OFF_FILT);
  bf16_t* YT = (bf16_t*)(p.ws + OFF_YT);
  const float* cw = p.in[15] + (size_t)j * 3 * 3072;
  const float* cb = p.in[16] + (size_t)j * 3072;
  const float* fbias = p.in[25] + (size_t)j * 2 * D;
  float2* buf0 = (float2*)lds;
  float2* bufH = buf0 + 8704;
  const int nitems = with_ctx ? 2048 : 1024;
  for (int it = blockIdx.x; it < nitems; it += G) {
    if (it < 1024) {
      const int d = it;
      float2 acc[16], r[16], xr[16];
      unsigned* zE = (unsigned*)bufH;
      unsigned* zO = zE + 8192;
#pragma unroll 1
      for (int part = 0; part < 2; ++part) {
        int tq = threadIdx.x;
        asm volatile("" : "+v"(tq));
        stage_rows(FILT + (size_t)(0 * 1024 + d) * SEQ, FILT + (size_t)(1 * 1024 + d) * SEQ, lds, tq);
        stage_rows(FILT + (size_t)(2 * 1024 + d) * SEQ, FILT + (size_t)(3 * 1024 + d) * SEQ, lds + 32768, tq);
        __syncthreads();
        const bf16_t* st = (const bf16_t*)lds;
#pragma unroll
        for (int i = 0; i < 16; ++i) {
          const int n = tq + 512 * i;
          const int nb = (n == 0) ? 0 : (SEQ - n);
          const float f0 = bf2f(st[n]), g0 = bf2f(st[SEQ + nb]);
          const float f1 = bf2f(st[2 * SEQ + n]), g1 = bf2f(st[3 * SEQ + nb]);
          if (part == 0) r[i] = make_float2(f0 + g0, f1 + g1);
          else {
            const float d0 = (n == 0) ? (f0 + g0) : (f0 - g0);
            const float d1 = (n == 0) ? (f1 + g1) : (f1 - g1);
            r[i] = cmul(make_float2(d0, d1), cexp_rev(-(float)n * (1.f / 16384.f)));
          }
        }
        __syncthreads();
        fft8192(r, buf0, tq);
        unsigned* zz = part ? zO : zE;
#pragma unroll
        for (int i = 0; i < 16; ++i) zz[tq + 512 * i] = pack2(r[i].x, r[i].y);
      }
      __syncthreads();
      {
        int t0 = threadIdx.x;
        asm volatile("" : "+v"(t0));
        const bf16_t* u0 = U + (size_t)d * MALL;
        stage_rows(u0, u0 + SEQ, lds, t0);
        __syncthreads();
        const bf16_t* st = (const bf16_t*)lds;
        const float w0 = cw[d], w1 = cw[3072 + d], w2 = cw[6144 + d], bb = cb[d];
#pragma unroll
        for (int i = 0; i < 16; ++i) {
          const int n = t0 + 512 * i;
          float vv[2];
#pragma unroll
          for (int b = 0; b < 2; ++b) {
            const bf16_t* ub = st + b * SEQ + n;
            const float um0 = bf2f(ub[(n > 0) ? -1 : 0]);
            const float uc = bf2f(ub[0]);
            const float up0 = bf2f(ub[(n < SEQ - 1) ? 1 : 0]);
            const float um = (n > 0) ? um0 : 0.f;
            const float up = (n < SEQ - 1) ? up0 : 0.f;
            vv[b] = um * w0 + uc * w1 + up * w2 + bb;
          }
          xr[i] = make_float2(vv[0], vv[1]);
        }
        __syncthreads();
      }
#pragma unroll 1
      for (int o = 0; o < 2; ++o) {
#pragma unroll 1
        for (int step = 1; step < 6; ++step) {
          if (step == 3) continue;
          int tq = threadIdx.x;
          asm volatile("" : "+v"(tq));
          if (step == 1) {
#pragma unroll
            for (int i = 0; i < 16; ++i) r[i] = xr[i];
          } else if (step == 4) {
#pragma unroll
            for (int i = 0; i < 16; ++i) {
              const int n = tq + 512 * i;
              r[i] = cmul(xr[i], cexp_rev(-(float)n * (1.f / 16384.f)));
            }
          }
          fft8192(r, buf0, tq);
          if (step == 1 || step == 4) {
            const unsigned* zz = (step == 1) ? zE : zO;
#pragma unroll
            for (int i = 0; i < 16; ++i) {
              const int k = tq + 512 * i;
              const int km = (step == 1) ? ((SEQ - k) & (SEQ - 1)) : (SEQ - 1 - k);
              const unsigned za = zz[k], zb = zz[km];
              const float2 Z = make_float2(__uint_as_float(za << 16), __uint_as_float(za & 0xffff0000u));
              const float2 Zm = make_float2(__uint_as_float(zb << 16), -__uint_as_float(zb & 0xffff0000u));
              float2 H;
              if (o == 0) H = make_float2(0.5f * (Z.x + Zm.x), 0.5f * (Z.y + Zm.y));
              else H = make_float2(0.5f * (Z.y - Zm.y), -0.5f * (Z.x - Zm.x));
              const float2 y = cmul(r[i], H);
              r[i] = make_float2(y.x, -y.y);
            }
          } else if (step == 2) {
#pragma unroll
            for (int i = 0; i < 16; ++i) acc[i] = make_float2(r[i].x, -r[i].y);
          } else {
#pragma unroll
            for (int i = 0; i < 16; ++i) {
              const int n = tq + 512 * i;
              const float2 wc = cexp_rev((float)n * (1.f / 16384.f));
              const float2 io = make_float2(r[i].x, -r[i].y);
              const float2 y = cmul(wc, io);
              acc[i] = make_float2((acc[i].x + y.x) * (1.f / 16384.f), (acc[i].y + y.y) * (1.f / 16384.f));
            }
          }
        }
        const int gc = (o == 0) ? (1024 + d) : (2048 + d);
        const bf16_t* ug = U + (size_t)gc * MALL;
        const float w0 = cw[gc], w1 = cw[3072 + gc], w2 = cw[6144 + gc], bb = cb[gc];
        const float fb = fbias[o * D + d];
        int te = threadIdx.x;
        asm volatile("" : "+v"(te));
        stage_rows(ug, ug + SEQ, lds, te);
        __syncthreads();
        const bf16_t* stg = (const bf16_t*)lds;
#pragma unroll
        for (int i = 0; i < 16; ++i) {
          const int n = te + 512 * i;
          float gg[2];
#pragma unroll
          for (int b = 0; b < 2; ++b) {
            const bf16_t* ub = stg + b * SEQ + n;
            const float um0 = bf2f(ub[(n > 0) ? -1 : 0]);
            const float uc = bf2f(ub[0]);
            const float up0 = bf2f(ub[(n < SEQ - 1) ? 1 : 0]);
            const float um = (n > 0) ? um0 : 0.f;
            const float up = (n < SEQ - 1) ? up0 : 0.f;
            gg[b] = um * w0 + uc * w1 + up * w2 + bb;
          }
          const float2 xv = xr[i];
          const float z0 = gg[0] * (acc[i].x + xv.x * fb);
          const float z1 = gg[1] * (acc[i].y + xv.y * fb);
          if (o == 0) xr[i] = make_float2(z0, z1);
          else {
            YT[(size_t)d * MALL + n] = f2bf(z0);
            YT[(size_t)d * MALL + SEQ + n] = f2bf(z1);
          }
        }
        __syncthreads();
      }
    } else {
      const int d = it - 1024;
      const int tc = tid_();
      float* Fc = (float*)lds;
      float* zs = Fc + 1024;
      const float* hid = (const float*)(p.ws + OFF_HID3C) + (size_t)j * 256 * 64;
      const float* wout = p.in[23] + (size_t)j * 64 * 4096;
      const float delta = fabsf(-3.0701134573253945f + (float)d * ((-15.350567286626973f + 3.0701134573253945f) / 1023.f));
#pragma unroll
      for (int i = 0; i < 2; ++i) {
        const int idx = tc + 512 * i;
        const int od = idx >> 8, t = idx & 255;
        float s = 0.f;
        for (int h = 0; h < 64; ++h) s += hid[t * 64 + h] * wout[(size_t)h * 4096 + od * 1024 + d];
        Fc[idx] = s * __expf(-(float)t * (1.f / 255.f) * delta);
      }
      const int b = tc >> 8, t = tc & 255;
      float sc3[3];
#pragma unroll
      for (int c3 = 0; c3 < 3; ++c3) {
        const int col = c3 * 1024 + d;
        const bf16_t* ub = U + (size_t)col * MALL + MLAT + b * CTXL + t;
        const float um0 = bf2f(ub[(t > 0) ? -1 : 0]);
        const float uc = bf2f(ub[0]);
        const float up0 = bf2f(ub[(t < CTXL - 1) ? 1 : 0]);
        const float um = (t > 0) ? um0 : 0.f;
        const float up = (t < CTXL - 1) ? up0 : 0.f;
        sc3[c3] = um * cw[col] + uc * cw[3072 + col] + up * cw[6144 + col] + cb[col];
      }
      float zin = sc3[0];
#pragma unroll 1
      for (int o = 0; o < 2; ++o) {
        __syncthreads();
        zs[b * 256 + t] = zin;
        __syncthreads();
        const float* fwd = Fc + (o * 2) * 256;
        const float* bwd = fwd + 256;
        float a = 0.f;
        for (int s = 0; s < 256; ++s) {
          const int dd = t - s;
          const float tap = (dd > 0) ? fwd[dd] : ((dd < 0) ? bwd[-dd] : (fwd[0] + bwd[0]));
          a += tap * zs[b * 256 + s];
        }
        const float res = sc3[1 + o] * (a + zin * fbias[o * D + d]);
        if (o == 0) zin = res;
        else YT[(size_t)d * MALL + MLAT + b * CTXL + t] = f2bf(res);
      }
      __syncthreads();
    }
  }
}

__device__ __forceinline__ void transpose_y_phase(const Params& p, int ntok, char* lds) {
  const int G = gridDim.x, tid = tid_();
  const bf16_t* YT = (const bf16_t*)(p.ws + OFF_YT);
  bf16_t* YB = (bf16_t*)(p.ws + OFF_OB);
  unsigned* T = (unsigned*)lds;
  const int ntt = ntok >> 7;
  const int lane = tid & 63, w = tid >> 6;
  const int ch = lane >> 2, dp = (lane & 3) + 4 * w;
  for (int t = blockIdx.x; t < 16 * ntt; t += G) {
    const int dt = t / ntt, tt = t - dt * ntt;
    {
      const bf16_t* g = YT + (size_t)(dt * 64 + 2 * dp) * MALL + tt * 128 + ch * 8;
      const uint4 a = *(const uint4*)(g);
      const uint4 c = *(const uint4*)(g + MALL);
      unsigned* tp = T + (ch * 8) * 33 + dp;
      tp[0 * 33] = (a.x & 0xffffu) | (c.x << 16);  tp[1 * 33] = (a.x >> 16) | (c.x & 0xffff0000u);
      tp[2 * 33] = (a.y & 0xffffu) | (c.y << 16);  tp[3 * 33] = (a.y >> 16) | (c.y & 0xffff0000u);
      tp[4 * 33] = (a.z & 0xffffu) | (c.z << 16);  tp[5 * 33] = (a.z >> 16) | (c.z & 0xffff0000u);
      tp[6 * 33] = (a.w & 0xffffu) | (c.w << 16);  tp[7 * 33] = (a.w >> 16) | (c.w & 0xffff0000u);
    }
    __syncthreads();
#pragma unroll
    for (int i = 0; i < 2; ++i) {
      const int idx = tid + 512 * i;
      const int tk = idx >> 3, q = idx & 7;
      const unsigned* tp = T + tk * 33 + q * 4;
      uint4 o;
      o.x = tp[0]; o.y = tp[1]; o.z = tp[2]; o.w = tp[3];
      *(uint4*)(YB + (size_t)(tt * 128 + tk) * D + dt * 64 + q * 8) = o;
    }
    __syncthreads();
  }
}

#define XB_TMO      128
#define XB_XCNT(j)  (256  + 64 * (j))
#define XB_XSUB(j)  (1280 + 64 * (j))
#define XB_XGEN(j)  (2304 + 64 * (j))
#define XB_TOP      3328
#define XB_TOPGEN   3392
#define XCD_BAR_WORDS 3456
#define XB_SPIN_CAP (1u << 18)
#define LAS __attribute__((address_space(3)))

__device__ __forceinline__ unsigned xb_ld(unsigned* p)              { return __hip_atomic_load(p, __ATOMIC_RELAXED, __HIP_MEMORY_SCOPE_AGENT); }
__device__ __forceinline__ unsigned xb_add(unsigned* p, unsigned v) { return __hip_atomic_fetch_add(p, v, __ATOMIC_RELAXED, __HIP_MEMORY_SCOPE_AGENT); }
__device__ __forceinline__ unsigned xb_xcc_id() { return (unsigned)__builtin_amdgcn_s_getreg((3 << 11) | 20) & 0xFu; }
#define XB_SPIN(cond, bar) do { unsigned _sp = 0; while (cond) { __builtin_amdgcn_s_sleep(1); \
    if ((++_sp & 255u) == 0u) { if (xb_ld(&(bar)[XB_TMO])) break; if (_sp > XB_SPIN_CAP) { atomicAdd(&(bar)[XB_TMO], 1u); break; } } } } while (0)

struct XcdBarrier {
    unsigned* bar; unsigned x;
    volatile LAS unsigned* st;
};

__device__ __forceinline__ XcdBarrier xcd_barrier_post(unsigned* bar, volatile LAS unsigned* st) {
    XcdBarrier b; b.bar = bar; b.x = xb_xcc_id(); b.st = st;
    if (threadIdx.x == 0) (void)xb_add(&bar[XB_XCNT(b.x)], 1u);
    return b;
}
__device__ __forceinline__ void xcd_barrier_complete(unsigned* bar, unsigned x, unsigned& nloc, unsigned& nx) {
    const unsigned G = gridDim.x * gridDim.y * gridDim.z;
    unsigned sum, cnt, mine, sp = 0u;
    for (;;) {
        sum = 0u; cnt = 0u; mine = 0u;
#pragma unroll
        for (unsigned j = 0; j < 16; ++j) { const unsigned c = xb_ld(&bar[XB_XCNT(j)]); sum += c; cnt += (c > 0u) ? 1u : 0u; mine = (j == x) ? c : mine; }
        if (sum == G) break;
        __builtin_amdgcn_s_sleep(1);
        if ((++sp & 255u) == 0u) { if (xb_ld(&bar[XB_TMO])) break; if (sp > XB_SPIN_CAP) { atomicAdd(&bar[XB_TMO], 1u); break; } }
    }
    nloc = mine > 0u ? mine : 1u; nx = cnt > 0u ? cnt : 1u;
}

__device__ __forceinline__ void xcd_barrier(const XcdBarrier& b) {
    asm volatile("s_waitcnt vmcnt(0)" ::: "memory");
    __syncthreads();
    if (threadIdx.x == 0) {
        unsigned* bar = b.bar;
        __builtin_amdgcn_s_waitcnt(0);
        unsigned nloc = b.st[0], nx = b.st[1];
        if (nloc == 0u) { xcd_barrier_complete(bar, b.x, nloc, nx); b.st[0] = nloc; b.st[1] = nx; }
        const unsigned old = xb_add(&bar[XB_XSUB(b.x)], 1u);
        const unsigned gen = old / nloc;
        if (old + 1u == (gen + 1u) * nloc) {
            __builtin_amdgcn_fence(__ATOMIC_RELEASE, "agent");
            asm volatile("s_waitcnt vmcnt(0)" ::: "memory");
            const unsigned og = xb_add(&bar[XB_TOP], 1u);
            const unsigned tg = og / nx;
            if (og + 1u == (tg + 1u) * nx) xb_add(&bar[XB_TOPGEN], 1u);
            else XB_SPIN(xb_ld(&bar[XB_TOPGEN]) == tg, bar);
            __builtin_amdgcn_fence(__ATOMIC_ACQUIRE, "agent");
            xb_add(&bar[XB_XGEN(b.x)], 1u);
            asm volatile("s_waitcnt vmcnt(0)" ::: "memory");
        } else {
            XB_SPIN(xb_ld(&bar[XB_XGEN(b.x)]) == gen, bar);
            __builtin_amdgcn_fence(__ATOMIC_ACQUIRE, "agent");
            asm volatile("s_waitcnt vmcnt(0)" ::: "memory");
        }
    }
    __syncthreads();
}


__device__ __forceinline__ void grid_barrier(unsigned* ctr, unsigned target) {
  asm volatile("s_waitcnt vmcnt(0)" ::: "memory");
  __syncthreads();
  if (threadIdx.x == 0) {
    __builtin_amdgcn_fence(__ATOMIC_RELEASE, "agent");
    asm volatile("s_waitcnt vmcnt(0)" ::: "memory");
    __hip_atomic_fetch_add(ctr, 1u, __ATOMIC_RELAXED, __HIP_MEMORY_SCOPE_AGENT);
    while (__hip_atomic_load(ctr, __ATOMIC_RELAXED, __HIP_MEMORY_SCOPE_AGENT) < target) __builtin_amdgcn_s_sleep(1);
    __builtin_amdgcn_fence(__ATOMIC_ACQUIRE, "agent");
  }
  __syncthreads();
}

__global__ void __launch_bounds__(NTHR, 2) fwd_megakernel(Params p) {
  extern __shared__ __attribute__((aligned(16))) char lds[];
  cg::grid_group grid = cg::this_grid();
  {
    volatile LAS unsigned* xst = (volatile LAS unsigned*)(lds + 139248);
    if (threadIdx.x < 4) xst[threadIdx.x] = 0u;
    __syncthreads();
  }
  if (blockIdx.x == 0) {
    unsigned* bw = (unsigned*)(p.ws + OFF_BAR);
    for (int i = threadIdx.x; i < 4096; i += NTHR) bw[i] = 0u;
  }
  XcdBarrier xbar;
  xbar.bar = (unsigned*)(p.ws + OFF_BAR); xbar.x = xb_xcc_id(); xbar.st = (volatile LAS unsigned*)(lds + 139248);
  char* ws = p.ws;
  unsigned nbar = 0;
  for (int ph = p.ph_lo; ph < p.ph_hi; ++ph) {
    int ptype = 8;
    if (ph > 0) {
      const int sub_ = (ph - 1) % 10, l_ = (ph - 1) / 10;
      ptype = (sub_ == 0 || sub_ == 3 || sub_ == 7) ? 0 : (sub_ == 1 || sub_ == 8) ? 1 : (sub_ == 2 || sub_ == 9) ? 2 : (sub_ == 6) ? 5 : (sub_ == 4) ? ((l_ & 1) ? 6 : 3) : ((l_ & 1) ? 7 : 4);
    }
    const int nrep = ((PROBE_MASK >> ptype) & 1) ? 2 : 1;
    for (int rep = 0; rep < nrep; ++rep) {
    if (rep > 0) { xcd_barrier(xbar); }
    if (ph == 0) {
      p0_prologue(p, lds);
    } else {
      const int l = (ph - 1) / 10, sub = (ph - 1) % 10;
      const bool is_attn = (l & 1) == 0;
      const int mi2 = l >> 1;
      const int rows = (l < 3) ? MALL : MLAT;
      const int MT = rows / 256;
      const float* MODL = (const float*)(ws + OFF_MOD) + (size_t)l * 3 * 9216;
      Epi e{};
      e.S = (float*)(ws + OFF_S);
      e.Sin = (l == 0 && sub == 2) ? p.in[0] : (const float*)(ws + OFF_S);
      if (sub == 0 || sub == 3 || sub == 7) {
        const int nparts = (sub == 0) ? ((l > 0) ? 11 : 0) : ((l < 3) ? ((sub == 3) ? 11 : 4) : 0);
        normmod_phase(p, l, sub == 0 ? 0 : (sub == 3 ? 1 : 2), rows, nparts);
      } else if (sub == 1 || sub == 8) {
        const int fi = l * 2 + (sub == 8);
        e.ob = (bf16_t*)(ws + OFF_ACT);
        gemm256_phase<EPI_SWIGLU>((const bf16_t*)(ws + OFF_HB), (const bf16_t*)(ws + OFF_WGU) + (size_t)fi * NGU * D, D, D / 64, MT, NGU / 256, lds, e, 0);
      } else if (sub == 2 || sub == 9 || sub == 6) {
        const bf16_t* A; const bf16_t* Bt; int K;
        e.out2 = nullptr; e.bias = nullptr;
        if (sub == 6) {
          if (!is_attn) {
            transpose_y_phase(p, rows, lds);
            xcd_barrier(xbar);
          }
          e.gate = MODL + 5 * D; e.coef = 1.f; K = D;
          A = (const bf16_t*)(ws + OFF_OB);
          if (is_attn) Bt = (const bf16_t*)(ws + OFF_WO) + (size_t)mi2 * D * D;
          else { Bt = (const bf16_t*)(ws + OFF_WHO) + (size_t)mi2 * D * D; e.bias = p.in[27] + (size_t)mi2 * D; }
        } else {
          const int fi = l * 2 + (sub == 9);
          e.gate = MODL + (sub == 2 ? 2 : 8) * D; e.coef = 0.5f; K = FF;
          A = (const bf16_t*)(ws + OFF_ACT);
          Bt = (const bf16_t*)(ws + OFF_WD) + (size_t)fi * D * FF;
          if (l == 3 && sub == 9) e.out2 = p.out;
        }
        if (rep + 1 < nrep) { e.coef = 0.f; e.out2 = nullptr; }
        const int nkt = K / 64;
        const int nlat = 256;
        const int nsplit = (l < 3) ? (nkt / 4) : 0;
        const int total = nlat + 8 * nsplit;
        const int G = gridDim.x;
        int bid = blockIdx.x;
        if ((G & 7) == 0) bid = (bid & 7) * (G >> 3) + (bid >> 3);
        for (int u = bid; u < total; u += G) {
          if (u < nlat) {
            e.atomic = 0;
            const int band = u >> 5, rem = u & 31;
            gemm256_tile<EPI_RESID>(A, Bt, K, 0, nkt, (band * 8 + (rem & 7)) * 256, (rem >> 3) * 256, lds, e, 0);
          } else {
            e.atomic = 1;
            e.part = (float*)(ws + OFF_PART);
            const int it = u - nlat;
            const int part = it >> 3, un = it & 7;
            gemm256_tile<EPI_RESID>(A, Bt, K, part * 4, 4, (64 + (un & 1)) * 256, (un >> 1) * 256, lds, e, part);
          }
        }
      } else if (sub == 4) {
        if (is_attn) {
          e.q = (bf16_t*)(ws + OFF_Q); e.kb = (bf16_t*)(ws + OFF_KB);
          e.qn = p.in[11] + mi2 * 64; e.kn = p.in[12] + mi2 * 64;
          const bf16_t* W = (const bf16_t*)(ws + OFF_WQKV) + (size_t)mi2 * 1536 * D;
          gemm256_phase<EPI_QK>((const bf16_t*)(ws + OFF_HB), W, D, D / 64, MT, 5, lds, e, 0);
          Epi e2{};
          e2.ob = (bf16_t*)(ws + OFF_VT); e2.ldo = NKEY; e2.vmode = 1; e2.bias = nullptr;
          gemm256_phase<EPI_T>(W + (size_t)1280 * D, (const bf16_t*)(ws + OFF_HB), D, D / 64, 1, MT, lds, e2, MT * 5);
        } else {
          Epi e2{};
          e2.ob = (bf16_t*)(ws + OFF_ACT); e2.ldo = MALL; e2.vmode = 0;
          e2.bias = p.in[14] + (size_t)mi2 * 3072;
          gemm256_phase<EPI_T>((const bf16_t*)(ws + OFF_WIN) + (size_t)mi2 * 3072 * D, (const bf16_t*)(ws + OFF_HB), D, D / 64, 12, MT, lds, e2, 0);
          Epi e3{};
          e3.ob = (bf16_t*)(ws + OFF_FILT);
          gemm256_phase<EPI_FILT>((const bf16_t*)(ws + OFF_WOUTT) + (size_t)mi2 * 4096 * 64, (const bf16_t*)(ws + OFF_HID3) + (size_t)mi2 * 8192 * 64, 64, 1, 16, 32, lds, e3, MT * 12);
        }
      } else if (sub == 5) {
        if (is_attn) attention_phase(p, mi2, lds);
        else hyena_conv_phase(p, mi2, l < 3, lds);
      }
    }
    }
    if (ph + 1 < p.ph_hi) {
      if (ph == 0) {
        grid.sync();
        if (threadIdx.x == 0) (void)xb_add(&xbar.bar[XB_XCNT(xbar.x)], 1u);
      }
      else { xcd_barrier(xbar); }
    }
  }
}

constexpr int LDS_BYTES = 139264;
constexpr int NPHASES = 41;

extern "C" void kernel_launch(void* const* d_in, const int* in_sizes, int n_in, void* d_out, int out_size,
                              void* d_ws, size_t ws_size, hipStream_t stream) {
  static int grid_blocks = 0;
  if (grid_blocks == 0) {
    if (ws_size < WS_END) { fprintf(stderr, "kernel_launch: workspace too small: %zu < %zu\n", ws_size, (size_t)WS_END); grid_blocks = -1; return; }
    int dev = 0, cus = 0, per_cu = 0;
    hipGetDevice(&dev);
    hipDeviceGetAttribute(&cus, hipDeviceAttributeMultiprocessorCount, dev);
    if (hipFuncSetAttribute((const void*)fwd_megakernel, hipFuncAttributeMaxDynamicSharedMemorySize, LDS_BYTES) != hipSuccess) {
      fprintf(stderr, "kernel_launch: hipFuncSetAttribute failed\n"); grid_blocks = -1; return;
    }
    hipOccupancyMaxActiveBlocksPerMultiprocessor(&per_cu, (const void*)fwd_megakernel, NTHR, LDS_BYTES);
    if (per_cu < 1) { fprintf(stderr, "kernel_launch: occupancy query says %d blocks/CU\n", per_cu); per_cu = 1; }
    grid_blocks = cus * 1;
    (void)hipGetLastError();
  }
  if (grid_blocks < 0) return;
  Params p{};
  for (int i = 0; i < 28; ++i) p.in[i] = (const float*)d_in[i];
  p.out = (float*)d_out;
  p.ws = (char*)d_ws;
  p.ph_lo = 0;
  p.ph_hi = NPHASES;
  void* args[] = {&p};
  hipError_t e = hipLaunchCooperativeKernel((const void*)fwd_megakernel, dim3(grid_blocks), dim3(NTHR), args, LDS_BYTES, stream);
  if (e != hipSuccess) fprintf(stderr, "cooperative launch failed: %s (grid %d)\n", hipGetErrorString(e), grid_blocks);
}
```

```cpp
#include <hip/hip_runtime.h>
#include <hip/hip_cooperative_groups.h>
#include <cstdio>
#include <cstdint>
namespace cg = cooperative_groups;

typedef unsigned short bf16_t;
typedef __attribute__((ext_vector_type(8))) short bf16x8;
typedef __attribute__((ext_vector_type(4))) float f32x4;
typedef __attribute__((ext_vector_type(16))) float f32x16;
typedef __attribute__((ext_vector_type(4))) unsigned u32x4;
typedef __attribute__((ext_vector_type(2))) float f32x2;

#define NTHR 512
#ifndef PROBE_MASK
#define PROBE_MASK 0
#endif
constexpr int D = 1024, FF = 2816, NGU = 5632, SEQ = 8192, CTXL = 256, MLAT = 16384, MALL = 16896, NKEY = 8448;
constexpr float EPSN = 1e-6f;

constexpr size_t OFF_BAR = 0;
constexpr size_t OFF_MOD = 16384;
constexpr size_t OFF_HID3 = OFF_MOD + 442368;
constexpr size_t OFF_HID3C = OFF_HID3 + 2097152;
constexpr size_t OFF_WOUTT = OFF_HID3C + 131072;
constexpr size_t OFF_WGU = OFF_WOUTT + 1048576;
constexpr size_t OFF_WD = OFF_WGU + 92274688;
constexpr size_t OFF_WQKV = OFF_WD + 46137344;
constexpr size_t OFF_WO = OFF_WQKV + 6291456;
constexpr size_t OFF_WIN = OFF_WO + 4194304;
constexpr size_t OFF_WHO = OFF_WIN + 12582912;
constexpr size_t OFF_S = OFF_WHO + 4194304;
constexpr size_t OFF_HB = OFF_S + 69206016;
constexpr size_t OFF_ACT = OFF_HB + 34603008;
constexpr size_t OFF_Q = OFF_ACT + 95158272;
constexpr size_t OFF_KB = OFF_Q + 34603008;
constexpr size_t OFF_VT = OFF_KB + 8650752;
constexpr size_t OFF_OB = OFF_VT + 8650752;
constexpr size_t OFF_FILT = OFF_OB + 34603008;
constexpr size_t OFF_XS = OFF_FILT + 67108864;
constexpr size_t OFF_PART = OFF_XS + (size_t)512 * 65536;
constexpr size_t OFF_YT = OFF_PART + (size_t)11 * 512 * 1024 * 4;
constexpr size_t WS_END = OFF_YT + (size_t)1024 * 16896 * 2;

struct Params {
  const float* in[28];
  float* out;
  char* ws;
  int ph_lo, ph_hi;
};

__device__ __forceinline__ int tid_() { int t = threadIdx.x; asm volatile("" : "+v"(t)); return t; }
__device__ __forceinline__ bf16_t f2bf(float f) {
  unsigned u = __float_as_uint(f);
  u += 0x7fffu + ((u >> 16) & 1u);
  return (bf16_t)(u >> 16);
}
__device__ __forceinline__ float bf2f(bf16_t h) { return __uint_as_float(((unsigned)h) << 16); }

__device__ __forceinline__ unsigned cvt_pk_bf16(float lo, float hi) { unsigned r; asm volatile("v_cvt_pk_bf16_f32 %0, %1, %2" : "=v"(r) : "v"(lo), "v"(hi)); return r; }
__device__ __forceinline__ unsigned pack2(float a, float b) { return cvt_pk_bf16(a, b); }
__device__ __forceinline__ float silu_f(float x) { return x * __builtin_amdgcn_rcpf(1.f + __expf(-x)); }
__device__ __forceinline__ int swz(int row, int ch) { return row * 128 + ((ch ^ ((row >> 1) & 7)) << 4); }
__device__ __forceinline__ float2 cmul(float2 a, float2 b) { return make_float2(a.x * b.x - a.y * b.y, a.x * b.y + a.y * b.x); }
__device__ __forceinline__ float2 cexp_rev(float rev) { return make_float2(__builtin_amdgcn_cosf(rev), __builtin_amdgcn_sinf(rev)); }

enum { EPI_SWIGLU = 0, EPI_RESID = 1, EPI_QK = 2, EPI_T = 3, EPI_FILT = 4 };

struct Epi {
  float* S; const float* Sin; float* out2; const float* gate; const float* bias; float coef;
  bf16_t* ob; int ldo; int vmode; int atomic; float* part;
  bf16_t* q; bf16_t* kb; const float* qn; const float* kn;
};

__device__ __forceinline__ int swz32(int row, int ch) { return row * 64 + ((ch ^ ((0 - (row >> 2)) & 3)) << 4); }

template <int EPI>
__device__ __forceinline__ void gemm256_tile(const bf16_t* A, const bf16_t* Bt, int ld, int kt0, int nkt, int m0, int n0, char* lds, const Epi& e, int part) {
  const int tid = tid_(), lane = tid & 63, w = __builtin_amdgcn_readfirstlane(tid >> 6);
  const int wm = w >> 2, wn = w & 3;
  const int fr = lane & 15, fq = lane >> 4;
  f32x4 acc[8][4];
#pragma unroll
  for (int i = 0; i < 8; ++i)
#pragma unroll
    for (int j = 0; j < 4; ++j) acc[i][j] = (f32x4){0.f, 0.f, 0.f, 0.f};
  unsigned soff[2];
#pragma unroll
  for (int i = 0; i < 2; ++i) {
    const int r = 16 * (w * 2 + i) + (lane >> 2);
    const int c = (lane & 3) ^ ((0 - (r >> 2)) & 3);
    soff[i] = (unsigned)(r * ld + c * 8);
  }
  const int nks = nkt * 2;
  const bf16_t* Ab = A + (size_t)m0 * ld + (size_t)kt0 * 64;
  const bf16_t* Bb = Bt + (size_t)n0 * ld + (size_t)kt0 * 64;
  char* ldsw = lds + w * 2048;
#define G256_ISSUE(step)                                                                                                        \
  do {                                                                                                                          \
    const int st_ = (step) < nks ? (step) : (nks - 1);                                                                          \
    char* dA_ = ldsw + ((step) & 3) * 32768;                                                                                    \
    const bf16_t* ga_ = Ab + (size_t)st_ * 32;                                                                                  \
    const bf16_t* gb_ = Bb + (size_t)st_ * 32;                                                                                  \
    __builtin_amdgcn_global_load_lds((const unsigned*)(ga_ + soff[0]), (unsigned*)(dA_), 16, 0, 0);                             \
    __builtin_amdgcn_global_load_lds((const unsigned*)(ga_ + soff[1]), (unsigned*)(dA_ + 1024), 16, 0, 0);                      \
    __builtin_amdgcn_global_load_lds((const unsigned*)(gb_ + soff[0]), (unsigned*)(dA_ + 16384), 16, 0, 0);                     \
    __builtin_amdgcn_global_load_lds((const unsigned*)(gb_ + soff[1]), (unsigned*)(dA_ + 16384 + 1024), 16, 0, 0);              \
  } while (0)
  G256_ISSUE(0);
  G256_ISSUE(1);
  G256_ISSUE(2);
  for (int t = 0; t < nks; ++t) {
    asm volatile("s_waitcnt vmcnt(8) lgkmcnt(0)" ::: "memory");
    __builtin_amdgcn_s_barrier();
    asm volatile("" ::: "memory");
    const char* cA = lds + (t & 3) * 32768;
    const char* cB = cA + 16384;
    bf16x8 bfr[4];
#pragma unroll
    for (int ni = 0; ni < 4; ++ni) bfr[ni] = *(const bf16x8*)(cB + swz32(wn * 64 + ni * 16 + fr, fq));
#pragma unroll
    for (int mh = 0; mh < 2; ++mh) {
      if (mh == 1) G256_ISSUE(t + 3);
      bf16x8 af[4];
#pragma unroll
      for (int mi = 0; mi < 4; ++mi) af[mi] = *(const bf16x8*)(cA + swz32(wm * 128 + (mh * 4 + mi) * 16 + fr, fq));
#pragma unroll
      for (int mi = 0; mi < 4; ++mi)
#pragma unroll
        for (int ni = 0; ni < 4; ++ni)
          acc[mh * 4 + mi][ni] = __builtin_amdgcn_mfma_f32_16x16x32_bf16(bfr[ni], af[mi], acc[mh * 4 + mi][ni], 0, 0, 0);
    }
  }
  asm volatile("s_waitcnt vmcnt(0)" ::: "memory");
  __syncthreads();
#undef G256_ISSUE
  const int rbase = m0 + wm * 128 + fr;
  const int cbase = n0 + wn * 64 + 4 * fq;
  if (EPI == EPI_SWIGLU) {
#pragma unroll
    for (int mi = 0; mi < 8; ++mi) {
      const int rl = wm * 128 + mi * 16 + fr;
#pragma unroll
      for (int nj = 0; nj < 2; ++nj) {
        const int fl = wn * 32 + nj * 16 + 4 * fq;
        const f32x4 g = acc[mi][2 * nj], u = acc[mi][2 * nj + 1];
        uint2 pk;
        pk.x = pack2(silu_f(g[0]) * u[0], silu_f(g[1]) * u[1]);
        pk.y = pack2(silu_f(g[2]) * u[2], silu_f(g[3]) * u[3]);
        *(uint2*)(lds + rl * 272 + fl * 2) = pk;
      }
    }
    __syncthreads();
    {
      bf16_t* dst = e.ob + (size_t)m0 * FF + (n0 >> 1);
#pragma unroll
      for (int i = 0; i < 8; ++i) {
        const int c = tid + 512 * i;
        const int rl = c >> 4, ch = c & 15;
        const uint4 v = *(const uint4*)(lds + rl * 272 + ch * 16);
        *(uint4*)(dst + (size_t)rl * FF + ch * 8) = v;
      }
    }
    __syncthreads();
  } else if (EPI == EPI_RESID) {
    const int grp = (m0 < SEQ) ? 0 : ((m0 < MLAT) ? 1 : 2);
#pragma unroll
    for (int ni = 0; ni < 4; ++ni) {
      const int col = cbase + ni * 16;
      float4 g = *(const float4*)(e.gate + grp * 9216 + col);
      g.x *= e.coef; g.y *= e.coef; g.z *= e.coef; g.w *= e.coef;
      float4 bv = make_float4(0.f, 0.f, 0.f, 0.f);
      if (e.bias && part == 0) bv = *(const float4*)(e.bias + col);
#pragma unroll
      for (int mi = 0; mi < 8; ++mi) {
        const int row = rbase + mi * 16;
        const size_t idx = (size_t)row * D + col;
        const f32x4 a = acc[mi][ni];
        if (e.atomic) {
          float4 o4;
          o4.x = g.x * (a[0] + bv.x); o4.y = g.y * (a[1] + bv.y); o4.z = g.z * (a[2] + bv.z); o4.w = g.w * (a[3] + bv.w);
          *(float4*)(e.part + ((size_t)part * 512 + (row - MLAT)) * D + col) = o4;
        } else {
          float4 s4 = *(const float4*)(e.Sin + idx);
          s4.x += g.x * (a[0] + bv.x); s4.y += g.y * (a[1] + bv.y); s4.z += g.z * (a[2] + bv.z); s4.w += g.w * (a[3] + bv.w);
          *(float4*)(e.S + idx) = s4;
          if (e.out2 && row < MLAT) *(float4*)(e.out2 + idx) = s4;
        }
      }
    }
  } else if (EPI == EPI_QK) {
    const int hcol0 = n0 + wn * 64;
    const bool isq = hcol0 < 1024;
    const float* nw = isq ? e.qn : e.kn;
    float4 nwv[4];
#pragma unroll
    for (int ni = 0; ni < 4; ++ni) nwv[ni] = *(const float4*)(nw + ni * 16 + 4 * fq);
    float freq[4];
#pragma unroll
    for (int i = 0; i < 4; ++i) freq[i] = exp2f(-(float)(4 * fq + i) * (13.287712379549449f / 16.f)) * 0.15915494309189535f;
    const float qs = isq ? (0.125f * 1.4426950408889634f) : 1.f;
#pragma unroll
    for (int mi = 0; mi < 8; ++mi) {
      const int row = rbase + mi * 16;
      f32x4 v[4];
      float ss = 0.f;
#pragma unroll
      for (int ni = 0; ni < 4; ++ni) { v[ni] = acc[mi][ni]; ss += v[ni][0] * v[ni][0] + v[ni][1] * v[ni][1] + v[ni][2] * v[ni][2] + v[ni][3] * v[ni][3]; }
      ss += __shfl_xor(ss, 16); ss += __shfl_xor(ss, 32);
      const float rstd = rsqrtf(ss * (1.f / 64.f) + EPSN);
#pragma unroll
      for (int ni = 0; ni < 4; ++ni) {
        v[ni][0] *= rstd * nwv[ni].x; v[ni][1] *= rstd * nwv[ni].y; v[ni][2] *= rstd * nwv[ni].z; v[ni][3] *= rstd * nwv[ni].w;
      }
      if (row < MLAT) {
        const int t = row & (SEQ - 1);
        const float pr = (float)(t >> 6), pc = (float)(t & 63);
#pragma unroll
        for (int i = 0; i < 4; ++i) {
          const float ar = pr * freq[i], ac = pc * freq[i];
          const float cr = __builtin_amdgcn_cosf(ar), sr = __builtin_amdgcn_sinf(ar);
          const float cc = __builtin_amdgcn_cosf(ac), sc = __builtin_amdgcn_sinf(ac);
          const float a0 = v[0][i] * cr - v[1][i] * sr, a1 = v[0][i] * sr + v[1][i] * cr;
          const float a2 = v[2][i] * cc - v[3][i] * sc, a3 = v[2][i] * sc + v[3][i] * cc;
          v[0][i] = a0; v[1][i] = a1; v[2][i] = a2; v[3][i] = a3;
        }
      }
      bf16_t* dst;
      if (isq) dst = e.q + (size_t)row * D + hcol0 + 4 * fq;
      else {
        const int kvh = (hcol0 - 1024) >> 6;
        int b, pos;
        if (row < MLAT) { b = row >> 13; pos = CTXL + (row & (SEQ - 1)); }
        else { b = (row - MLAT) >> 8; pos = (row - MLAT) & 255; }
        dst = e.kb + ((size_t)(b * 4 + kvh) * NKEY + pos) * 64 + 4 * fq;
      }
#pragma unroll
      for (int ni = 0; ni < 4; ++ni) {
        uint2 pk;
        pk.x = pack2(v[ni][0] * qs, v[ni][1] * qs);
        pk.y = pack2(v[ni][2] * qs, v[ni][3] * qs);
        *(uint2*)(dst + ni * 16) = pk;
      }
    }
  } else if (EPI == EPI_T) {
#pragma unroll
    for (int ni = 0; ni < 4; ++ni) {
      const int tok = cbase + ni * 16;
      size_t cm = (size_t)tok;
      if (e.vmode) {
        int b, pos;
        if (tok < MLAT) { b = tok >> 13; pos = CTXL + (tok & (SEQ - 1)); }
        else { b = (tok - MLAT) >> 8; pos = (tok - MLAT) & 255; }
        cm = (size_t)b * 256 * NKEY + pos;
      }
#pragma unroll
      for (int mi = 0; mi < 8; ++mi) {
        const int row = rbase + mi * 16;
        const float bv = e.bias ? e.bias[row] : 0.f;
        const f32x4 a = acc[mi][ni];
        uint2 pk;
        pk.x = pack2(a[0] + bv, a[1] + bv);
        pk.y = pack2(a[2] + bv, a[3] + bv);
        *(uint2*)(e.ob + (size_t)row * e.ldo + cm) = pk;
      }
    }
  } else if (EPI == EPI_FILT) {
#pragma unroll
    for (int mi = 0; mi < 8; ++mi) {
      const int row = rbase + mi * 16;
      const int d = row & 1023;
      const float delta = fabsf(-3.0701134573253945f + (float)d * ((-15.350567286626973f + 3.0701134573253945f) / 1023.f));
      const float dk = -delta * (1.f / 8191.f);
#pragma unroll
      for (int ni = 0; ni < 4; ++ni) {
        const int t = cbase + ni * 16;
        const f32x4 a = acc[mi][ni];
        uint2 pk;
        pk.x = pack2(a[0] * __expf((float)t * dk), a[1] * __expf((float)(t + 1) * dk));
        pk.y = pack2(a[2] * __expf((float)(t + 2) * dk), a[3] * __expf((float)(t + 3) * dk));
        *(uint2*)(e.ob + (size_t)row * SEQ + t) = pk;
      }
    }
  }
}

template <int EPI>
__device__ __forceinline__ void gemm256_phase(const bf16_t* A, const bf16_t* Bt, int ld, int nkt, int MT, int NTn, char* lds, const Epi& e, int rot) {
  const int G = gridDim.x;
  const int total = MT * NTn;
  int bid = (int)((blockIdx.x + G - (rot % G)) % G);
  if ((G & 7) == 0) bid = (bid & 7) * (G >> 3) + (bid >> 3);
  for (int u = bid; u < total; u += G) {
    const int band = u / (8 * NTn);
    const int rem = u - band * 8 * NTn;
    const int gsz = min(8, MT - band * 8);
    const int nt = rem / gsz, mt = band * 8 + (rem - nt * gsz);
    gemm256_tile<EPI>(A, Bt, ld, 0, nkt, mt * 256, nt * 256, lds, e, 0);
  }
}

__device__ __forceinline__ void convert_matrix(const float* src, int K, int N, bf16_t* dst, int perm, char* lds, int& rot) {
  const int G = gridDim.x, tid = tid_();
  const int tn = N >> 8, tk = K >> 6, total = tn * tk;
  bf16_t* T = (bf16_t*)lds;
  const int kr0 = tid >> 6, c4 = tid & 63;
  int t = (int)((blockIdx.x + G - (rot % G)) % G);
  float4 v[8];
  if (t < total) {
    const int kt = t / tn, ntile = t - kt * tn;
    const float* g = src + (size_t)((kt << 6) + kr0) * N + (ntile << 8) + c4 * 4;
#pragma unroll
    for (int i = 0; i < 8; ++i) v[i] = *(const float4*)(g + (size_t)(8 * i) * N);
  }
  for (; t < total; t += G) {
    const int kt = t / tn, ntile = t - kt * tn;
    const int k0 = kt << 6, n0 = ntile << 8;
#pragma unroll
    for (int i = 0; i < 8; ++i) {
      const int kr = kr0 + 8 * i;
      T[(c4 * 4 + 0) * 72 + kr] = f2bf(v[i].x);
      T[(c4 * 4 + 1) * 72 + kr] = f2bf(v[i].y);
      T[(c4 * 4 + 2) * 72 + kr] = f2bf(v[i].z);
      T[(c4 * 4 + 3) * 72 + kr] = f2bf(v[i].w);
    }
    const int t2 = t + G;
    if (t2 < total) {
      const int kt2 = t2 / tn, nt2 = t2 - kt2 * tn;
      const float* g = src + (size_t)((kt2 << 6) + kr0) * N + (nt2 << 8) + c4 * 4;
#pragma unroll
      for (int i = 0; i < 8; ++i) v[i] = *(const float4*)(g + (size_t)(8 * i) * N);
    }
    __syncthreads();
#pragma unroll
    for (int i = 0; i < 4; ++i) {
      const int idx = tid + 512 * i;
      const int n = idx >> 3, ch = idx & 7;
      const uint4 o = *(const uint4*)(T + n * 72 + ch * 8);
      int ng = n0 + n;
      if (perm) {
        if (ng < FF) ng = ((ng >> 4) << 5) + (ng & 15);
        else { const int f = ng - FF; ng = ((f >> 4) << 5) + 16 + (f & 15); }
      }
      *(uint4*)(dst + (size_t)ng * K + k0 + ch * 8) = o;
    }
    __syncthreads();
  }
  rot += total;
}

__device__ __forceinline__ void p0_prologue(const Params& p, char* lds) {
  const int G = gridDim.x, tid = tid_(), lane = tid & 63, w = tid >> 6;
  char* ws = p.ws;
  {
    float4* S4 = (float4*)(ws + OFF_S);
    const float4* x4 = (const float4*)p.in[0];
    const float4* c4 = (const float4*)p.in[2];
    const size_t nlat = (size_t)MLAT * D / 4, nall = (size_t)MALL * D / 4;
    (void)x4;
    for (size_t i = nlat + (size_t)blockIdx.x * NTHR + tid; i < nall; i += (size_t)G * NTHR)
      S4[i] = c4[i - nlat];
  }
  {
    float* MOD = (float*)(ws + OFF_MOD);
    const float* c = p.in[1];
    const float* cc = p.in[3];
    float* red = (float*)lds;
    for (int it = blockIdx.x; it < 4 * 144; it += G) {
      const int l = it / 144, c0 = (it - l * 144) * 64;
      const int cg4 = lane & 15, kq = lane >> 4;
      float a[3][4];
#pragma unroll
      for (int g = 0; g < 3; ++g)
#pragma unroll
        for (int j = 0; j < 4; ++j) a[g][j] = 0.f;
      const float* wb = p.in[4] + (size_t)l * D * 9216 + c0 + cg4 * 4;
#pragma unroll 4
      for (int i = 0; i < 32; ++i) {
        const int k = w * 128 + i * 4 + kq;
        const float4 wv = *(const float4*)(wb + (size_t)k * 9216);
        const float s0 = silu_f(c[k]), s1 = silu_f(c[D + k]), s2 = silu_f(cc[k]);
        a[0][0] += s0 * wv.x; a[0][1] += s0 * wv.y; a[0][2] += s0 * wv.z; a[0][3] += s0 * wv.w;
        a[1][0] += s1 * wv.x; a[1][1] += s1 * wv.y; a[1][2] += s1 * wv.z; a[1][3] += s1 * wv.w;
        a[2][0] += s2 * wv.x; a[2][1] += s2 * wv.y; a[2][2] += s2 * wv.z; a[2][3] += s2 * wv.w;
      }
#pragma unroll
      for (int g = 0; g < 3; ++g)
#pragma unroll
        for (int j = 0; j < 4; ++j) {
          float v = a[g][j];
          v += __shfl_xor(v, 16); v += __shfl_xor(v, 32);
          a[g][j] = v;
        }
      if (kq == 0) {
#pragma unroll
        for (int g = 0; g < 3; ++g)
#pragma unroll
          for (int j = 0; j < 4; ++j) red[(w * 3 + g) * 64 + cg4 * 4 + j] = a[g][j];
      }
      __syncthreads();
      if (tid < 192) {
        const int g = tid >> 6, col = tid & 63;
        float s = 0.f;
#pragma unroll
        for (int ww = 0; ww < 8; ++ww) s += red[(ww * 3 + g) * 64 + col];
        MOD[(size_t)(l * 3 + g) * 9216 + c0 + col] = s + p.in[5][(size_t)l * 9216 + c0 + col];
      }
      __syncthreads();
    }
  }
  {
    int rot = 0;
    for (int i = 0; i < 8; ++i) convert_matrix(p.in[7] + (size_t)i * D * NGU, D, NGU, (bf16_t*)(ws + OFF_WGU) + (size_t)i * NGU * D, 1, lds, rot);
    for (int i = 0; i < 8; ++i) convert_matrix(p.in[8] + (size_t)i * FF * D, FF, D, (bf16_t*)(ws + OFF_WD) + (size_t)i * D * FF, 0, lds, rot);
    for (int i = 0; i < 2; ++i) convert_matrix(p.in[9] + (size_t)i * D * 1536, D, 1536, (bf16_t*)(ws + OFF_WQKV) + (size_t)i * 1536 * D, 0, lds, rot);
    for (int i = 0; i < 2; ++i) convert_matrix(p.in[10] + (size_t)i * D * D, D, D, (bf16_t*)(ws + OFF_WO) + (size_t)i * D * D, 0, lds, rot);
    for (int i = 0; i < 2; ++i) convert_matrix(p.in[13] + (size_t)i * D * 3072, D, 3072, (bf16_t*)(ws + OFF_WIN) + (size_t)i * 3072 * D, 0, lds, rot);
    for (int i = 0; i < 2; ++i) convert_matrix(p.in[26] + (size_t)i * D * D, D, D, (bf16_t*)(ws + OFF_WHO) + (size_t)i * D * D, 0, lds, rot);
    for (int i = 0; i < 2; ++i) convert_matrix(p.in[23] + (size_t)i * 64 * 4096, 64, 4096, (bf16_t*)(ws + OFF_WOUTT) + (size_t)i * 4096 * 64, 0, lds, rot);
  }
  {
    float* W1 = (float*)lds;
    float* W2 = W1 + 33 * 64;
    float* W3 = W2 + 64 * 64;
    float* feat = W3 + 64 * 64;
    float* h1 = feat + 8 * 40;
    float* h2 = h1 + 8 * 64;
    const int tt = tid >> 6, h = tid & 63;
    const int per = 256 + 8;
    int jcur = -1;
    for (int it = blockIdx.x; it < 2 * per; it += G) {
      const int j = it / per;
      int r = it - j * per;
      const int Lsel = (r >= 256);
      if (Lsel) r -= 256;
      const int L = Lsel ? 256 : 8192;
      if (j != jcur) {
        __syncthreads();
        for (int i = tid; i < 33 * 64; i += NTHR) W1[i] = p.in[17][(size_t)j * 33 * 64 + i];
        for (int i = tid; i < 64 * 64; i += NTHR) { W2[i] = p.in[19][(size_t)j * 4096 + i]; W3[i] = p.in[21][(size_t)j * 4096 + i]; }
        jcur = j;
        __syncthreads();
      }
      const float a = p.in[24][j * 64 + h];
      const float b1 = p.in[18][j * 64 + h], b2 = p.in[20][j * 64 + h], b3 = p.in[22][j * 64 + h];
      for (int sub = 0; sub < 4; ++sub) {
        const int t = r * 32 + sub * 8 + tt;
        if (h < 33) {
          const float tl = (float)t / (float)(L - 1);
          const float wv = (6.2831855f * (float)t) / (float)L;
          float f;
          if (h == 0) f = tl;
          else {
            const int bi = (h - 1) & 15;
            const float band = 1e-4f + (float)bi * ((15.f - 1e-4f) / 15.f);
            const float ang = band * wv;
            f = (h <= 16) ? __cosf(ang) : -__sinf(ang);
          }
          feat[tt * 40 + h] = f;
        }
        __syncthreads();
        {
          float s = b1;
#pragma unroll
          for (int e2 = 0; e2 < 33; ++e2) s += feat[tt * 40 + e2] * W1[e2 * 64 + h];
          h1[tt * 64 + h] = __sinf(a * s);
        }
        __syncthreads();
        {
          float s = b2;
#pragma unroll 16
          for (int k = 0; k < 64; ++k) s += h1[tt * 64 + k] * W2[k * 64 + h];
          h2[tt * 64 + h] = __sinf(a * s);
        }
        __syncthreads();
        {
          float s = b3;
#pragma unroll 16
          for (int k = 0; k < 64; ++k) s += h2[tt * 64 + k] * W3[k * 64 + h];
          const float v = __sinf(a * s);
          if (Lsel) ((float*)(ws + OFF_HID3C))[((size_t)j * 256 + t) * 64 + h] = v;
          else ((bf16_t*)(ws + OFF_HID3))[((size_t)j * 8192 + t) * 64 + h] = f2bf(v);
        }
      }
    }
    __syncthreads();
  }
}

__device__ __forceinline__ void normmod_phase(const Params& p, int l, int k, int rows, int nparts) {
  const int G = gridDim.x, tid = tid_(), lane = tid & 63, w = tid >> 6;
  float* S = (float*)(p.ws + OFF_S);
  const float* PART = (const float*)(p.ws + OFF_PART);
  bf16_t* HB = (bf16_t*)(p.ws + OFF_HB);
  const float* MOD = (const float*)(p.ws + OFF_MOD) + (size_t)l * 3 * 9216;
  const float* nw = p.in[6] + (size_t)(l * 3 + k) * D;
  const int stride = G * 8;
  for (int row0 = blockIdx.x * 8 + w; row0 < rows; row0 += 2 * stride) {
    float4 x[2][4];
    float ss[2] = {0.f, 0.f};
#pragma unroll
    for (int rr = 0; rr < 2; ++rr) {
      const int row = row0 + rr * stride;
      if (row < rows) {
#pragma unroll
        for (int q = 0; q < 4; ++q) x[rr][q] = *(const float4*)(((l == 0 && k == 0 && row < MLAT) ? p.in[0] : (const float*)S) + (size_t)row * D + q * 256 + lane * 4);
      } else {
#pragma unroll
        for (int q = 0; q < 4; ++q) x[rr][q] = make_float4(0.f, 0.f, 0.f, 0.f);
      }
    }
#pragma unroll
    for (int rr = 0; rr < 2; ++rr) {
      const int row = row0 + rr * stride;
      if (row < rows && row >= MLAT && nparts > 0) {
#pragma unroll
        for (int q = 0; q < 4; ++q) {
          for (int pp = 0; pp < nparts; ++pp) {
            const float4 t4 = *(const float4*)(PART + ((size_t)pp * 512 + (row - MLAT)) * D + q * 256 + lane * 4);
            x[rr][q].x += t4.x; x[rr][q].y += t4.y; x[rr][q].z += t4.z; x[rr][q].w += t4.w;
          }
          *(float4*)(S + (size_t)row * D + q * 256 + lane * 4) = x[rr][q];
        }
      }
#pragma unroll
      for (int q = 0; q < 4; ++q) ss[rr] += x[rr][q].x * x[rr][q].x + x[rr][q].y * x[rr][q].y + x[rr][q].z * x[rr][q].z + x[rr][q].w * x[rr][q].w;
    }
#pragma unroll
    for (int o = 1; o < 64; o <<= 1) { ss[0] += __shfl_xor(ss[0], o); ss[1] += __shfl_xor(ss[1], o); }
#pragma unroll
    for (int rr = 0; rr < 2; ++rr) {
      const int row = row0 + rr * stride;
      if (row < rows) {
        const int grp = (row < SEQ) ? 0 : ((row < MLAT) ? 1 : 2);
        const float* sh = MOD + grp * 9216 + (3 * k) * D;
        const float* sc = sh + D;
        const float rstd = rsqrtf(ss[rr] * (1.f / 1024.f) + EPSN);
#pragma unroll
        for (int q = 0; q < 4; ++q) {
          const int c = q * 256 + lane * 4;
          const float4 g = *(const float4*)(nw + c);
          const float4 s1 = *(const float4*)(sc + c);
          const float4 s0 = *(const float4*)(sh + c);
          uint2 pk;
          pk.x = pack2(x[rr][q].x * rstd * g.x * (1.f + s1.x) + s0.x, x[rr][q].y * rstd * g.y * (1.f + s1.y) + s0.y);
          pk.y = pack2(x[rr][q].z * rstd * g.z * (1.f + s1.z) + s0.z, x[rr][q].w * rstd * g.w * (1.f + s1.w) + s0.w);
          *(uint2*)(HB + (size_t)row * D + c) = pk;
        }
      }
    }
  }
}

__device__ __forceinline__ void attention_phase(const Params& p, int ai, char* lds) {
  const int G = gridDim.x, tid = tid_(), lane = tid & 63, w = tid >> 6;
  const int l31 = lane & 31, hh = lane >> 5;
  const bf16_t* Q = (const bf16_t*)(p.ws + OFF_Q);
  const bf16_t* KB = (const bf16_t*)(p.ws + OFF_KB);
  const bf16_t* VT = (const bf16_t*)(p.ws + OFF_VT);
  bf16_t* OB = (bf16_t*)(p.ws + OFF_OB);
  const int lrow = tid >> 3, lch = tid & 7;
  float sbound;
  {
    float mq = fabsf(p.in[11][ai * 64 + lane]), mk = fabsf(p.in[12][ai * 64 + lane]);
#pragma unroll
    for (int o = 1; o < 64; o <<= 1) { mq = fmaxf(mq, __shfl_xor(mq, o)); mk = fmaxf(mk, __shfl_xor(mk, o)); }
    sbound = fminf(8.f * mq * mk * 1.4426950408889634f, 100.f);
  }
  for (int it = blockIdx.x; it < 1024 + 32; it += G) {
    int b, head, rowbase, nT;
    if (it < 1024) { b = it >> 9; head = (it >> 5) & 15; rowbase = b * SEQ + (it & 31) * 256; nT = NKEY / 64; }
    else { const int r = it - 1024; b = r >> 4; head = r & 15; rowbase = MLAT + b * CTXL; nT = CTXL / 64; }
    const int kvh = head >> 2;
    const bf16_t* kp = KB + ((size_t)(b * 4 + kvh) * NKEY + lrow) * 64 + lch * 8;
    const bf16_t* vp = VT + ((size_t)(b * 4 + kvh) * 64 + lrow) * NKEY + lch * 8;
    bf16x8 qf[4];
    {
      const bf16_t* qp = Q + (size_t)(rowbase + w * 32 + l31) * D + head * 64 + hh * 8;
#pragma unroll
      for (int ks = 0; ks < 4; ++ks) qf[ks] = *(const bf16x8*)(qp + ks * 16);
    }
    f32x16 o0, o1;
#pragma unroll
    for (int i = 0; i < 16; ++i) { o0[i] = 0.f; o1[i] = 0.f; }
    f32x16 negm;
#pragma unroll
    for (int i = 0; i < 16; ++i) negm[i] = -sbound;
    float lsa = 0.f, lsb = 0.f;
    uint4 rk = *(const uint4*)(kp);
    uint4 rv = *(const uint4*)(vp);
    *(uint4*)(lds + swz(lrow, lch)) = rk;
    *(uint2*)(lds + 16384 + lrow * 136 + lch * 16) = make_uint2(rv.x, rv.y);
    *(uint2*)(lds + 16384 + lrow * 136 + lch * 16 + 8) = make_uint2(rv.z, rv.w);
    __syncthreads();
    for (int kt = 0; kt < nT; ++kt) {
      char* cK = lds + (kt & 1) * 8192;
      char* cV = lds + 16384 + (kt & 1) * 8704;
      const bool more = (kt + 1 < nT);
      if (more) {
        rk = *(const uint4*)(kp + (size_t)(kt + 1) * 64 * 64);
        rv = *(const uint4*)(vp + (kt + 1) * 64);
      }
      f32x16 s0, s1;
      {
        const bf16x8 a0 = *(const bf16x8*)(cK + swz(l31, hh));
        const bf16x8 a1 = *(const bf16x8*)(cK + swz(l31 + 32, hh));
        s0 = __builtin_amdgcn_mfma_f32_32x32x16_bf16(a0, qf[0], negm, 0, 0, 0);
        s1 = __builtin_amdgcn_mfma_f32_32x32x16_bf16(a1, qf[0], negm, 0, 0, 0);
      }
#pragma unroll
      for (int ks = 1; ks < 4; ++ks) {
        const bf16x8 a0 = *(const bf16x8*)(cK + swz(l31, 2 * ks + hh));
        const bf16x8 a1 = *(const bf16x8*)(cK + swz(l31 + 32, 2 * ks + hh));
        s0 = __builtin_amdgcn_mfma_f32_32x32x16_bf16(a0, qf[ks], s0, 0, 0, 0);
        s1 = __builtin_amdgcn_mfma_f32_32x32x16_bf16(a1, qf[ks], s1, 0, 0, 0);
      }
#pragma unroll
      for (int i = 0; i < 16; i += 2) {
        s0[i] = __builtin_amdgcn_exp2f(s0[i]); s0[i + 1] = __builtin_amdgcn_exp2f(s0[i + 1]);
        s1[i] = __builtin_amdgcn_exp2f(s1[i]); s1[i + 1] = __builtin_amdgcn_exp2f(s1[i + 1]);
        lsa += s0[i] + s1[i];
        lsb += s0[i + 1] + s1[i + 1];
      }
      bf16x8 pf[4];
#pragma unroll
      for (int j = 0; j < 4; ++j) {
        u32x4 cv;
#pragma unroll
        for (int q2 = 0; q2 < 4; ++q2) {
          const int i0 = 8 * (j & 1) + 2 * q2;
          const float x0 = (j < 2) ? s0[i0] : s1[i0];
          const float x1 = (j < 2) ? s0[i0 + 1] : s1[i0 + 1];
          cv[q2] = cvt_pk_bf16(x0, x1);
        }
        pf[j] = __builtin_bit_cast(bf16x8, cv);
      }
#pragma unroll
      for (int j = 0; j < 4; ++j) {
        const char* r0 = cV + l31 * 136 + j * 32 + hh * 8;
        const char* r1 = cV + (l31 + 32) * 136 + j * 32 + hh * 8;
        const uint2 x0 = *(const uint2*)(r0), x1 = *(const uint2*)(r0 + 16);
        const uint2 y0 = *(const uint2*)(r1), y1 = *(const uint2*)(r1 + 16);
        const u32x4 v0 = {x0.x, x0.y, x1.x, x1.y};
        const u32x4 v1 = {y0.x, y0.y, y1.x, y1.y};
        o0 = __builtin_amdgcn_mfma_f32_32x32x16_bf16(__builtin_bit_cast(bf16x8, v0), pf[j], o0, 0, 0, 0);
        o1 = __builtin_amdgcn_mfma_f32_32x32x16_bf16(__builtin_bit_cast(bf16x8, v1), pf[j], o1, 0, 0, 0);
      }
      if (more) {
        char* nK = lds + ((kt + 1) & 1) * 8192;
        char* nV = lds + 16384 + ((kt + 1) & 1) * 8704;
        *(uint4*)(nK + swz(lrow, lch)) = rk;
        *(uint2*)(nV + lrow * 136 + lch * 16) = make_uint2(rv.x, rv.y);
        *(uint2*)(nV + lrow * 136 + lch * 16 + 8) = make_uint2(rv.z, rv.w);
      }
      __syncthreads();
    }
    float lsum = lsa + lsb;
    lsum += __shfl_xor(lsum, 32);
    const float inv = 1.f / lsum;
    bf16_t* op = OB + (size_t)(rowbase + w * 32 + l31) * D + head * 64 + hh * 4;
#pragma unroll
    for (int g4 = 0; g4 < 4; ++g4) {
      uint2 pk;
      pk.x = pack2(o0[g4 * 4 + 0] * inv, o0[g4 * 4 + 1] * inv);
      pk.y = pack2(o0[g4 * 4 + 2] * inv, o0[g4 * 4 + 3] * inv);
      *(uint2*)(op + g4 * 8) = pk;
      pk.x = pack2(o1[g4 * 4 + 0] * inv, o1[g4 * 4 + 1] * inv);
      pk.y = pack2(o1[g4 * 4 + 2] * inv, o1[g4 * 4 + 3] * inv);
      *(uint2*)(op + 32 + g4 * 8) = pk;
    }
  }
}

__device__ __forceinline__ void dft16(float2 (&v)[16]) {
  float2 t[4][4];
#pragma unroll
  for (int a = 0; a < 4; ++a) {
    const float2 x0 = v[a], x1 = v[a + 4], x2 = v[a + 8], x3 = v[a + 12];
    const float2 s0 = make_float2(x0.x + x2.x, x0.y + x2.y), s1 = make_float2(x0.x - x2.x, x0.y - x2.y);
    const float2 s2 = make_float2(x1.x + x3.x, x1.y + x3.y), s3 = make_float2(x1.x - x3.x, x1.y - x3.y);
    t[a][0] = make_float2(s0.x + s2.x, s0.y + s2.y);
    t[a][1] = make_float2(s1.x + s3.y, s1.y - s3.x);
    t[a][2] = make_float2(s0.x - s2.x, s0.y - s2.y);
    t[a][3] = make_float2(s1.x - s3.y, s1.y + s3.x);
  }
  const float C1 = 0.92387953251128674f, S1 = 0.38268343236508977f, R2 = 0.70710678118654752f;
  t[1][1] = cmul(t[1][1], make_float2(C1, -S1));
  t[1][2] = cmul(t[1][2], make_float2(R2, -R2));
  t[1][3] = cmul(t[1][3], make_float2(S1, -C1));
  t[2][1] = cmul(t[2][1], make_float2(R2, -R2));
  t[2][2] = make_float2(t[2][2].y, -t[2][2].x);
  t[2][3] = cmul(t[2][3], make_float2(-R2, -R2));
  t[3][1] = cmul(t[3][1], make_float2(S1, -C1));
  t[3][2] = cmul(t[3][2], make_float2(-R2, -R2));
  t[3][3] = cmul(t[3][3], make_float2(-C1, S1));
#pragma unroll
  for (int c = 0; c < 4; ++c) {
    const float2 x0 = t[0][c], x1 = t[1][c], x2 = t[2][c], x3 = t[3][c];
    const float2 s0 = make_float2(x0.x + x2.x, x0.y + x2.y), s1 = make_float2(x0.x - x2.x, x0.y - x2.y);
    const float2 s2 = make_float2(x1.x + x3.x, x1.y + x3.y), s3 = make_float2(x1.x - x3.x, x1.y - x3.y);
    v[c] = make_float2(s0.x + s2.x, s0.y + s2.y);
    v[c + 4] = make_float2(s1.x + s3.y, s1.y - s3.x);
    v[c + 8] = make_float2(s0.x - s2.x, s0.y - s2.y);
    v[c + 12] = make_float2(s1.x - s3.y, s1.y + s3.x);
  }
}

__device__ __forceinline__ void r16_pass(float2 (&r)[16], float2* buf, int tid, int Ns) {
  const int k = tid & (Ns - 1);
  if (Ns > 1) {
    const float2 w1 = cexp_rev(-(float)k / (float)(16 * Ns));
    float2 w = w1;
#pragma unroll
    for (int i = 1; i < 16; ++i) {
      r[i] = cmul(r[i], w);
      w = cmul(w, w1);
    }
  }
  dft16(r);
  const int j0 = ((tid - k) << 4) + k;
#pragma unroll
  for (int m = 0; m < 16; ++m) { const int ix = j0 + m * Ns; buf[ix + (ix >> 4)] = r[m]; }
}

__device__ __forceinline__ void fft8192(float2 (&r)[16], float2* buf, int tid) {
#pragma unroll
  for (int Ns = 1; Ns < 4096; Ns <<= 4) {
    r16_pass(r, buf, tid, Ns);
    __syncthreads();
#pragma unroll
    for (int i = 0; i < 16; ++i) { const int ix = tid + 512 * i; r[i] = buf[ix + (ix >> 4)]; }
    __syncthreads();
  }
#pragma unroll
  for (int b = 0; b < 8; ++b) {
    const int j = tid + 512 * b;
    const float2 a0 = r[b];
    const float2 a1 = cmul(r[b + 8], cexp_rev(-(float)j * (1.f / 8192.f)));
    r[b] = make_float2(a0.x + a1.x, a0.y + a1.y);
    r[b + 8] = make_float2(a0.x - a1.x, a0.y - a1.y);
  }
}

__device__ __forceinline__ void stage_rows(const bf16_t* r0, const bf16_t* r1, char* dst, int tid) {
#pragma unroll
  for (int i = 0; i < 4; ++i) {
    const int c = tid + 512 * i;
    const bf16_t* src = (c < 1024) ? (r0 + c * 8) : (r1 + (c - 1024) * 8);
    *(uint4*)(dst + c * 16) = *(const uint4*)src;
  }
}

__device__ __forceinline__ void hyena_conv_phase(const Params& p, int j, bool with_ctx, char* lds) {
  const int G = gridDim.x, tid = tid_();
  const bf16_t* U = (const bf16_t*)(p.ws + OFF_ACT);
  const bf16_t* FILT = (const bf16_t*)(p.ws + OFF_FILT);
  bf16_t* YT = (bf16_t*)(p.ws + OFF_YT);
  const float* cw = p.in[15] + (size_t)j * 3 * 3072;
  const float* cb = p.in[16] + (size_t)j * 3072;
  const float* fbias = p.in[25] + (size_t)j * 2 * D;
  float2* buf0 = (float2*)lds;
  float2* bufH = buf0 + 8704;
  const int nitems = with_ctx ? 2048 : 1024;
  for (int it = blockIdx.x; it < nitems; it += G) {
    if (it < 1024) {
      const int d = it;
      float2 acc[16], r[16], xr[16];
      unsigned* zE = (unsigned*)bufH;
      unsigned* zO = zE + 8192;
#pragma unroll 1
      for (int part = 0; part < 2; ++part) {
        int tq = threadIdx.x;
        asm volatile("" : "+v"(tq));
        stage_rows(FILT + (size_t)(0 * 1024 + d) * SEQ, FILT + (size_t)(1 * 1024 + d) * SEQ, lds, tq);
        stage_rows(FILT + (size_t)(2 * 1024 + d) * SEQ, FILT + (size_t)(3 * 1024 + d) * SEQ, lds + 32768, tq);
        __syncthreads();
        const bf16_t* st = (const bf16_t*)lds;
#pragma unroll
        for (int i = 0; i < 16; ++i) {
          const int n = tq + 512 * i;
          const int nb = (n == 0) ? 0 : (SEQ - n);
          const float f0 = bf2f(st[n]), g0 = bf2f(st[SEQ + nb]);
          const float f1 = bf2f(st[2 * SEQ + n]), g1 = bf2f(st[3 * SEQ + nb]);
          if (part == 0) r[i] = make_float2(f0 + g0, f1 + g1);
          else {
            const float d0 = (n == 0) ? (f0 + g0) : (f0 - g0);
            const float d1 = (n == 0) ? (f1 + g1) : (f1 - g1);
            r[i] = cmul(make_float2(d0, d1), cexp_rev(-(float)n * (1.f / 16384.f)));
          }
        }
        __syncthreads();
        fft8192(r, buf0, tq);
        unsigned* zz = part ? zO : zE;
#pragma unroll
        for (int i = 0; i < 16; ++i) zz[tq + 512 * i] = pack2(r[i].x, r[i].y);
      }
      __syncthreads();
      {
        int t0 = threadIdx.x;
        asm volatile("" : "+v"(t0));
        const bf16_t* u0 = U + (size_t)d * MALL;
        stage_rows(u0, u0 + SEQ, lds, t0);
        __syncthreads();
        const bf16_t* st = (const bf16_t*)lds;
        const float w0 = cw[d], w1 = cw[3072 + d], w2 = cw[6144 + d], bb = cb[d];
#pragma unroll
        for (int i = 0; i < 16; ++i) {
          const int n = t0 + 512 * i;
          float vv[2];
#pragma unroll
          for (int b = 0; b < 2; ++b) {
            const bf16_t* ub = st + b * SEQ + n;
            const float um0 = bf2f(ub[(n > 0) ? -1 : 0]);
            const float uc = bf2f(ub[0]);
            const float up0 = bf2f(ub[(n < SEQ - 1) ? 1 : 0]);
            const float um = (n > 0) ? um0 : 0.f;
            const float up = (n < SEQ - 1) ? up0 : 0.f;
            vv[b] = um * w0 + uc * w1 + up * w2 + bb;
          }
          xr[i] = make_float2(vv[0], vv[1]);
        }
        __syncthreads();
      }
#pragma unroll 1
      for (int o = 0; o < 2; ++o) {
#pragma unroll 1
        for (int step = 1; step < 6; ++step) {
          if (step == 3) continue;
          int tq = threadIdx.x;
          asm volatile("" : "+v"(tq));
          if (step == 1) {
#pragma unroll
            for (int i = 0; i < 16; ++i) r[i] = xr[i];
          } else if (step == 4) {
#pragma unroll
            for (int i = 0; i < 16; ++i) {
              const int n = tq + 512 * i;
              r[i] = cmul(xr[i], cexp_rev(-(float)n * (1.f / 16384.f)));
            }
          }
          fft8192(r, buf0, tq);
          if (step == 1 || step == 4) {
            const unsigned* zz = (step == 1) ? zE : zO;
#pragma unroll
            for (int i = 0; i < 16; ++i) {
              const int k = tq + 512 * i;
              const int km = (step == 1) ? ((SEQ - k) & (SEQ - 1)) : (SEQ - 1 - k);
              const unsigned za = zz[k], zb = zz[km];
              const float2 Z = make_float2(__uint_as_float(za << 16), __uint_as_float(za & 0xffff0000u));
              const float2 Zm = make_float2(__uint_as_float(zb << 16), -__uint_as_float(zb & 0xffff0000u));
              float2 H;
              if (o == 0) H = make_float2(0.5f * (Z.x + Zm.x), 0.5f * (Z.y + Zm.y));
              else H = make_float2(0.5f * (Z.y - Zm.y), -0.5f * (Z.x - Zm.x));
              const float2 y = cmul(r[i], H);
              r[i] = make_float2(y.x, -y.y);
            }
          } else if (step == 2) {
#pragma unroll
            for (int i = 0; i < 16; ++i) acc[i] = make_float2(r[i].x, -r[i].y);
          } else {
#pragma unroll
            for (int i = 0; i < 16; ++i) {
              const int n = tq + 512 * i;
              const float2 wc = cexp_rev((float)n * (1.f / 16384.f));
              const float2 io = make_float2(r[i].x, -r[i].y);
              const float2 y = cmul(wc, io);
              acc[i] = make_float2((acc[i].x + y.x) * (1.f / 16384.f), (acc[i].y + y.y) * (1.f / 16384.f));
            }
          }
        }
        const int gc = (o == 0) ? (1024 + d) : (2048 + d);
        const bf16_t* ug = U + (size_t)gc * MALL;
        const float w0 = cw[gc], w1 = cw[3072 + gc], w2 = cw[6144 + gc], bb = cb[gc];
        const float fb = fbias[o * D + d];
        int te = threadIdx.x;
        asm volatile("" : "+v"(te));
        stage_rows(ug, ug + SEQ, lds, te);
        __syncthreads();
        const bf16_t* stg = (const bf16_t*)lds;
#pragma unroll
        for (int i = 0; i < 16; ++i) {
          const int n = te + 512 * i;
          float gg[2];
#pragma unroll
          for (int b = 0; b < 2; ++b) {
            const bf16_t* ub = stg + b * SEQ + n;
            const float um0 = bf2f(ub[(n > 0) ? -1 : 0]);
            const float uc = bf2f(ub[0]);
            const float up0 = bf2f(ub[(n < SEQ - 1) ? 1 : 0]);
            const float um = (n > 0) ? um0 : 0.f;
            const float up = (n < SEQ - 1) ? up0 : 0.f;
            gg[b] = um * w0 + uc * w1 + up * w2 + bb;
          }
          const float2 xv = xr[i];
          const float z0 = gg[0] * (acc[i].x + xv.x * fb);
          const float z1 = gg[1] * (acc[i].y + xv.y * fb);
          if (o == 0) xr[i] = make_float2(z0, z1);
          else {
            YT[(size_t)d * MALL + n] = f2bf(z0);
            YT[(size_t)d * MALL + SEQ + n] = f2bf(z1);
          }
        }
        __syncthreads();
      }
    } else {
      const int d = it - 1024;
      const int tc = tid_();
      float* Fc = (float*)lds;
      float* zs = Fc + 1024;
      const float* hid = (const float*)(p.ws + OFF_HID3C) + (size_t)j * 256 * 64;
      const float* wout = p.in[23] + (size_t)j * 64 * 4096;
      const float delta = fabsf(-3.0701134573253945f + (float)d * ((-15.350567286626973f + 3.0701134573253945f) / 1023.f));
#pragma unroll
      for (int i = 0; i < 2; ++i) {
        const int idx = tc + 512 * i;
        const int od = idx >> 8, t = idx & 255;
        float s = 0.f;
        for (int h = 0; h < 64; ++h) s += hid[t * 64 + h] * wout[(size_t)h * 4096 + od * 1024 + d];
        Fc[idx] = s * __expf(-(float)t * (1.f / 255.f) * delta);
      }
      const int b = tc >> 8, t = tc & 255;
      float sc3[3];
#pragma unroll
      for (int c3 = 0; c3 < 3; ++c3) {
        const int col = c3 * 1024 + d;
        const bf16_t* ub = U + (size_t)col * MALL + MLAT + b * CTXL + t;
        const float um0 = bf2f(ub[(t > 0) ? -1 : 0]);
        const float uc = bf2f(ub[0]);
        const float up0 = bf2f(ub[(t < CTXL - 1) ? 1 : 0]);
        const float um = (t > 0) ? um0 : 0.f;
        const float up = (t < CTXL - 1) ? up0 : 0.f;
        sc3[c3] = um * cw[col] + uc * cw[3072 + col] + up * cw[6144 + col] + cb[col];
      }
      float zin = sc3[0];
#pragma unroll 1
      for (int o = 0; o < 2; ++o) {
        __syncthreads();
        zs[b * 256 + t] = zin;
        __syncthreads();
        const float* fwd = Fc + (o * 2) * 256;
        const float* bwd = fwd + 256;
        float a = 0.f;
        for (int s = 0; s < 256; ++s) {
          const int dd = t - s;
          const float tap = (dd > 0) ? fwd[dd] : ((dd < 0) ? bwd[-dd] : (fwd[0] + bwd[0]));
          a += tap * zs[b * 256 + s];
        }
        const float res = sc3[1 + o] * (a + zin * fbias[o * D + d]);
        if (o == 0) zin = res;
        else YT[(size_t)d * MALL + MLAT + b * CTXL + t] = f2bf(res);
      }
      __syncthreads();
    }
  }
}

__device__ __forceinline__ void transpose_y_phase(const Params& p, int ntok, char* lds) {
  const int G = gridDim.x, tid = tid_();
  const bf16_t* YT = (const bf16_t*)(p.ws + OFF_YT);
  bf16_t* YB = (bf16_t*)(p.ws + OFF_OB);
  unsigned* T = (unsigned*)lds;
  const int ntt = ntok >> 7;
  const int lane = tid & 63, w = tid >> 6;
  const int ch = lane >> 2, dp = (lane & 3) + 4 * w;
  for (int t = blockIdx.x; t < 16 * ntt; t += G) {
    const int dt = t / ntt, tt = t - dt * ntt;
    {
      const bf16_t* g = YT + (size_t)(dt * 64 + 2 * dp) * MALL + tt * 128 + ch * 8;
      const uint4 a = *(const uint4*)(g);
      const uint4 c = *(const uint4*)(g + MALL);
      unsigned* tp = T + (ch * 8) * 33 + dp;
      tp[0 * 33] = (a.x & 0xffffu) | (c.x << 16);  tp[1 * 33] = (a.x >> 16) | (c.x & 0xffff0000u);
      tp[2 * 33] = (a.y & 0xffffu) | (c.y << 16);  tp[3 * 33] = (a.y >> 16) | (c.y & 0xffff0000u);
      tp[4 * 33] = (a.z & 0xffffu) | (c.z << 16);  tp[5 * 33] = (a.z >> 16) | (c.z & 0xffff0000u);
      tp[6 * 33] = (a.w & 0xffffu) | (c.w << 16);  tp[7 * 33] = (a.w >> 16) | (c.w & 0xffff0000u);
    }
    __syncthreads();
#pragma unroll
    for (int i = 0; i < 2; ++i) {
      const int idx = tid + 512 * i;
      const int tk = idx >> 3, q = idx & 7;
      const unsigned* tp = T + tk * 33 + q * 4;
      uint4 o;
      o.x = tp[0]; o.y = tp[1]; o.z = tp[2]; o.w = tp[3];
      *(uint4*)(YB + (size_t)(tt * 128 + tk) * D + dt * 64 + q * 8) = o;
    }
    __syncthreads();
  }
}

#define XB_TMO      128
#define XB_XCNT(j)  (256  + 64 * (j))
#define XB_XSUB(j)  (1280 + 64 * (j))
#define XB_XGEN(j)  (2304 + 64 * (j))
#define XB_TOP      3328
#define XB_TOPGEN   3392
#define XCD_BAR_WORDS 3456
#define XB_SPIN_CAP (1u << 18)
#define LAS __attribute__((address_space(3)))

__device__ __forceinline__ unsigned xb_ld(unsigned* p)              { return __hip_atomic_load(p, __ATOMIC_RELAXED, __HIP_MEMORY_SCOPE_AGENT); }
__device__ __forceinline__ unsigned xb_add(unsigned* p, unsigned v) { return __hip_atomic_fetch_add(p, v, __ATOMIC_RELAXED, __HIP_MEMORY_SCOPE_AGENT); }
__device__ __forceinline__ unsigned xb_xcc_id() { return (unsigned)__builtin_amdgcn_s_getreg((3 << 11) | 20) & 0xFu; }
#define XB_SPIN(cond, bar) do { unsigned _sp = 0; while (cond) { __builtin_amdgcn_s_sleep(1); \
    if ((++_sp & 255u) == 0u) { if (xb_ld(&(bar)[XB_TMO])) break; if (_sp > XB_SPIN_CAP) { atomicAdd(&(bar)[XB_TMO], 1u); break; } } } } while (0)

struct XcdBarrier {
    unsigned* bar; unsigned x;
    volatile LAS unsigned* st;
};

__device__ __forceinline__ XcdBarrier xcd_barrier_post(unsigned* bar, volatile LAS unsigned* st) {
    XcdBarrier b; b.bar = bar; b.x = xb_xcc_id(); b.st = st;
    if (threadIdx.x == 0) (void)xb_add(&bar[XB_XCNT(b.x)], 1u);
    return b;
}
__device__ __forceinline__ void xcd_barrier_complete(unsigned* bar, unsigned x, unsigned& nloc, unsigned& nx) {
    const unsigned G = gridDim.x * gridDim.y * gridDim.z;
    unsigned sum, cnt, mine, sp = 0u;
    for (;;) {
        sum = 0u; cnt = 0u; mine = 0u;
#pragma unroll
        for (unsigned j = 0; j < 16; ++j) { const unsigned c = xb_ld(&bar[XB_XCNT(j)]); sum += c; cnt += (c > 0u) ? 1u : 0u; mine = (j == x) ? c : mine; }
        if (sum == G) break;
        __builtin_amdgcn_s_sleep(1);
        if ((++sp & 255u) == 0u) { if (xb_ld(&bar[XB_TMO])) break; if (sp > XB_SPIN_CAP) { atomicAdd(&bar[XB_TMO], 1u); break; } }
    }
    nloc = mine > 0u ? mine : 1u; nx = cnt > 0u ? cnt : 1u;
}

__device__ __forceinline__ void xcd_barrier(const XcdBarrier& b) {
    asm volatile("s_waitcnt vmcnt(0)" ::: "memory");
    __syncthreads();
    if (threadIdx.x == 0) {
        unsigned* bar = b.bar;
        __builtin_amdgcn_s_waitcnt(0);
        unsigned nloc = b.st[0], nx = b.st[1];
        if (nloc == 0u) { xcd_barrier_complete(bar, b.x, nloc, nx); b.st[0] = nloc; b.st[1] = nx; }
        const unsigned old = xb_add(&bar[XB_XSUB(b.x)], 1u);
        const unsigned gen = old / nloc;
        if (old + 1u == (gen + 1u) * nloc) {
            __builtin_amdgcn_fence(__ATOMIC_RELEASE, "agent");
            asm volatile("s_waitcnt vmcnt(0)" ::: "memory");
            const unsigned og = xb_add(&bar[XB_TOP], 1u);
            const unsigned tg = og / nx;
            if (og + 1u == (tg + 1u) * nx) xb_add(&bar[XB_TOPGEN], 1u);
            else XB_SPIN(xb_ld(&bar[XB_TOPGEN]) == tg, bar);
            __builtin_amdgcn_fence(__ATOMIC_ACQUIRE, "agent");
            xb_add(&bar[XB_XGEN(b.x)], 1u);
            asm volatile("s_waitcnt vmcnt(0)" ::: "memory");
        } else {
            XB_SPIN(xb_ld(&bar[XB_XGEN(b.x)]) == gen, bar);
            __builtin_amdgcn_fence(__ATOMIC_ACQUIRE, "agent");
            asm volatile("s_waitcnt vmcnt(0)" ::: "memory");
        }
    }
    __syncthreads();
}


__device__ __forceinline__ void grid_barrier(unsigned* ctr, unsigned target) {
  asm volatile("s_waitcnt vmcnt(0)" ::: "memory");
  __syncthreads();
  if (threadIdx.x == 0) {
    __builtin_amdgcn_fence(__ATOMIC_RELEASE, "agent");
    asm volatile("s_waitcnt vmcnt(0)" ::: "memory");
    __hip_atomic_fetch_add(ctr, 1u, __ATOMIC_RELAXED, __HIP_MEMORY_SCOPE_AGENT);
    while (__hip_atomic_load(ctr, __ATOMIC_RELAXED, __HIP_MEMORY_SCOPE_AGENT) < target) __builtin_amdgcn_s_sleep(1);
    __builtin_amdgcn_fence(__ATOMIC_ACQUIRE, "agent");
  }
  __syncthreads();
}

__global__ void __launch_bounds__(NTHR, 2) fwd_megakernel(Params p) {
  extern __shared__ __attribute__((aligned(16))) char lds[];
  cg::grid_group grid = cg::this_grid();
  {
    volatile LAS unsigned* xst = (volatile LAS unsigned*)(lds + 139248);
    if (threadIdx.x < 4) xst[threadIdx.x] = 0u;
    __syncthreads();
  }
  if (blockIdx.x == 0) {
    unsigned* bw = (unsigned*)(p.ws + OFF_BAR);
    for (int i = threadIdx.x; i < 4096; i += NTHR) bw[i] = 0u;
  }
  XcdBarrier xbar;
  xbar.bar = (unsigned*)(p.ws + OFF_BAR); xbar.x = xb_xcc_id(); xbar.st = (volatile LAS unsigned*)(lds + 139248);
  char* ws = p.ws;
  unsigned nbar = 0;
  for (int ph = p.ph_lo; ph < p.ph_hi; ++ph) {
    int ptype = 8;
    if (ph > 0) {
      const int sub_ = (ph - 1) % 10, l_ = (ph - 1) / 10;
      ptype = (sub_ == 0 || sub_ == 3 || sub_ == 7) ? 0 : (sub_ == 1 || sub_ == 8) ? 1 : (sub_ == 2 || sub_ == 9) ? 2 : (sub_ == 6) ? 5 : (sub_ == 4) ? ((l_ & 1) ? 6 : 3) : ((l_ & 1) ? 7 : 4);
    }
    const int nrep = ((PROBE_MASK >> ptype) & 1) ? 2 : 1;
    for (int rep = 0; rep < nrep; ++rep) {
    if (rep > 0) { xcd_barrier(xbar); }
    if (ph == 0) {
      p0_prologue(p, lds);
    } else {
      const int l = (ph - 1) / 10, sub = (ph - 1) % 10;
      const bool is_attn = (l & 1) == 0;
      const int mi2 = l >> 1;
      const int rows = (l < 3) ? MALL : MLAT;
      const int MT = rows / 256;
      const float* MODL = (const float*)(ws + OFF_MOD) + (size_t)l * 3 * 9216;
      Epi e{};
      e.S = (float*)(ws + OFF_S);
      e.Sin = (l == 0 && sub == 2) ? p.in[0] : (const float*)(ws + OFF_S);
      if (sub == 0 || sub == 3 || sub == 7) {
        const int nparts = (sub == 0) ? ((l > 0) ? 11 : 0) : ((l < 3) ? ((sub == 3) ? 11 : 4) : 0);
        normmod_phase(p, l, sub == 0 ? 0 : (sub == 3 ? 1 : 2), rows, nparts);
      } else if (sub == 1 || sub == 8) {
        const int fi = l * 2 + (sub == 8);
        e.ob = (bf16_t*)(ws + OFF_ACT);
        gemm256_phase<EPI_SWIGLU>((const bf16_t*)(ws + OFF_HB), (const bf16_t*)(ws + OFF_WGU) + (size_t)fi * NGU * D, D, D / 64, MT, NGU / 256, lds, e, 0);
      } else if (sub == 2 || sub == 9 || sub == 6) {
        const bf16_t* A; const bf16_t* Bt; int K;
        e.out2 = nullptr; e.bias = nullptr;
        if (sub == 6) {
          if (!is_attn) {
            transpose_y_phase(p, rows, lds);
            xcd_barrier(xbar);
          }
          e.gate = MODL + 5 * D; e.coef = 1.f; K = D;
          A = (const bf16_t*)(ws + OFF_OB);
          if (is_attn) Bt = (const bf16_t*)(ws + OFF_WO) + (size_t)mi2 * D * D;
          else { Bt = (const bf16_t*)(ws + OFF_WHO) + (size_t)mi2 * D * D; e.bias = p.in[27] + (size_t)mi2 * D; }
        } else {
          const int fi = l * 2 + (sub == 9);
          e.gate = MODL + (sub == 2 ? 2 : 8) * D; e.coef = 0.5f; K = FF;
          A = (const bf16_t*)(ws + OFF_ACT);
          Bt = (const bf16_t*)(ws + OFF_WD) + (size_t)fi * D * FF;
          if (l == 3 && sub == 9) e.out2 = p.out;
        }
        if (rep + 1 < nrep) { e.coef = 0.f; e.out2 = nullptr; }
        const int nkt = K / 64;
        const int nlat = 256;
        const int nsplit = (l < 3) ? (nkt / 4) : 0;
        const int total = nlat + 8 * nsplit;
        const int G = gridDim.x;
        int bid = blockIdx.x;
        if ((G & 7) == 0) bid = (bid & 7) * (G >> 3) + (bid >> 3);
        for (int u = bid; u < total; u += G) {
          if (u < nlat) {
            e.atomic = 0;
            const int band = u >> 5, rem = u & 31;
            gemm256_tile<EPI_RESID>(A, Bt, K, 0, nkt, (band * 8 + (rem & 7)) * 256, (rem >> 3) * 256, lds, e, 0);
          } else {
            e.atomic = 1;
            e.part = (float*)(ws + OFF_PART);
            const int it = u - nlat;
            const int part = it >> 3, un = it & 7;
            gemm256_tile<EPI_RESID>(A, Bt, K, part * 4, 4, (64 + (un & 1)) * 256, (un >> 1) * 256, lds, e, part);
          }
        }
      } else if (sub == 4) {
        if (is_attn) {
          e.q = (bf16_t*)(ws + OFF_Q); e.kb = (bf16_t*)(ws + OFF_KB);
          e.qn = p.in[11] + mi2 * 64; e.kn = p.in[12] + mi2 * 64;
          const bf16_t* W = (const bf16_t*)(ws + OFF_WQKV) + (size_t)mi2 * 1536 * D;
          gemm256_phase<EPI_QK>((const bf16_t*)(ws + OFF_HB), W, D, D / 64, MT, 5, lds, e, 0);
          Epi e2{};
          e2.ob = (bf16_t*)(ws + OFF_VT); e2.ldo = NKEY; e2.vmode = 1; e2.bias = nullptr;
          gemm256_phase<EPI_T>(W + (size_t)1280 * D, (const bf16_t*)(ws + OFF_HB), D, D / 64, 1, MT, lds, e2, MT * 5);
        } else {
          Epi e2{};
          e2.ob = (bf16_t*)(ws + OFF_ACT); e2.ldo = MALL; e2.vmode = 0;
          e2.bias = p.in[14] + (size_t)mi2 * 3072;
          gemm256_phase<EPI_T>((const bf16_t*)(ws + OFF_WIN) + (size_t)mi2 * 3072 * D, (const bf16_t*)(ws + OFF_HB), D, D / 64, 12, MT, lds, e2, 0);
          Epi e3{};
          e3.ob = (bf16_t*)(ws + OFF_FILT);
          gemm256_phase<EPI_FILT>((const bf16_t*)(ws + OFF_WOUTT) + (size_t)mi2 * 4096 * 64, (const bf16_t*)(ws + OFF_HID3) + (size_t)mi2 * 8192 * 64, 64, 1, 16, 32, lds, e3, MT * 12);
        }
      } else if (sub == 5) {
        if (is_attn) attention_phase(p, mi2, lds);
        else hyena_conv_phase(p, mi2, l < 3, lds);
      }
    }
    }
    if (ph + 1 < p.ph_hi) {
      if (ph == 0) {
        grid.sync();
        if (threadIdx.x == 0) (void)xb_add(&xbar.bar[XB_XCNT(xbar.x)], 1u);
      }
      else { xcd_barrier(xbar); }
    }
  }
}

constexpr int LDS_BYTES = 139264;
constexpr int NPHASES = 41;

extern "C" void kernel_launch(void* const* d_in, const int* in_sizes, int n_in, void* d_out, int out_size,
                              void* d_ws, size_t ws_size, hipStream_t stream) {
  static int grid_blocks = 0;
  if (grid_blocks == 0) {
    if (ws_size < WS_END) { fprintf(stderr, "kernel_launch: workspace too small: %zu < %zu\n", ws_size, (size_t)WS_END); grid_blocks = -1; return; }
    int dev = 0, cus = 0, per_cu = 0;
    hipGetDevice(&dev);
    hipDeviceGetAttribute(&cus, hipDeviceAttributeMultiprocessorCount, dev);
    if (hipFuncSetAttribute((const void*)fwd_megakernel, hipFuncAttributeMaxDynamicSharedMemorySize, LDS_BYTES) != hipSuccess) {
      fprintf(stderr, "kernel_launch: hipFuncSetAttribute failed\n"); grid_blocks = -1; return;
    }
    hipOccupancyMaxActiveBlocksPerMultiprocessor(&per_cu, (const void*)fwd_megakernel, NTHR, LDS_BYTES);
    if (per_cu < 1) { fprintf(stderr, "kernel_launch: occupancy query says %d blocks/CU\n", per_cu); per_cu = 1; }
    grid_blocks = cus * 1;
    (void)hipGetLastError();
  }
  if (grid_blocks < 0) return;
  Params p{};
  for (int i = 0; i < 28; ++i) p.in[i] = (const float*)d_in[i];
  p.out = (float*)d_out;
  p.ws = (char*)d_ws;
  p.ph_lo = 0;
  p.ph_hi = NPHASES;
  void* args[] = {&p};
  hipError_t e = hipLaunchCooperativeKernel((const void*)fwd_megakernel, dim3(grid_blocks), dim3(NTHR), args, LDS_BYTES, stream);
  if (e != hipSuccess) fprintf(stderr, "cooperative launch failed: %s (grid %d)\n", hipGetErrorString(e), grid_blocks);
}
```

```cpp
#include <hip/hip_runtime.h>
#include <hip/hip_cooperative_groups.h>
#include <cstdio>
#include <cstdint>
namespace cg = cooperative_groups;

typedef unsigned short bf16_t;
typedef __attribute__((ext_vector_type(8))) short bf16x8;
typedef __attribute__((ext_vector_type(4))) float f32x4;
typedef __attribute__((ext_vector_type(16))) float f32x16;
typedef __attribute__((ext_vector_type(4))) unsigned u32x4;
typedef __attribute__((ext_vector_type(2))) float f32x2;

#define NTHR 512
#ifndef PROBE_MASK
#define PROBE_MASK 0
#endif
constexpr int D = 1024, FF = 2816, NGU = 5632, SEQ = 8192, CTXL = 256, MLAT = 16384, MALL = 16896, NKEY = 8448;
constexpr float EPSN = 1e-6f;

constexpr size_t OFF_BAR = 0;
constexpr size_t OFF_MOD = 16384;
constexpr size_t OFF_HID3 = OFF_MOD + 442368;
constexpr size_t OFF_HID3C = OFF_HID3 + 2097152;
constexpr size_t OFF_WOUTT = OFF_HID3C + 131072;
constexpr size_t OFF_WGU = OFF_WOUTT + 1048576;
constexpr size_t OFF_WD = OFF_WGU + 92274688;
constexpr size_t OFF_WQKV = OFF_WD + 46137344;
constexpr size_t OFF_WO = OFF_WQKV + 6291456;
constexpr size_t OFF_WIN = OFF_WO + 4194304;
constexpr size_t OFF_WHO = OFF_WIN + 12582912;
constexpr size_t OFF_S = OFF_WHO + 4194304;
constexpr size_t OFF_HB = OFF_S + 69206016;
constexpr size_t OFF_ACT = OFF_HB + 34603008;
constexpr size_t OFF_Q = OFF_ACT + 95158272;
constexpr size_t OFF_KB = OFF_Q + 34603008;
constexpr size_t OFF_VT = OFF_KB + 8650752;
constexpr size_t OFF_OB = OFF_VT + 8650752;
constexpr size_t OFF_FILT = OFF_OB + 34603008;
constexpr size_t OFF_XS = OFF_FILT + 67108864;
constexpr size_t OFF_PART = OFF_XS + (size_t)512 * 65536;
constexpr size_t OFF_YT = OFF_PART + (size_t)11 * 512 * 1024 * 4;
constexpr size_t WS_END = OFF_YT + (size_t)1024 * 16896 * 2;

struct Params {
  const float* in[28];
  float* out;
  char* ws;
  int ph_lo, ph_hi;
};

__device__ __forceinline__ int tid_() { int t = threadIdx.x; asm volatile("" : "+v"(t)); return t; }
__device__ __forceinline__ bf16_t f2bf(float f) {
  unsigned u = __float_as_uint(f);
  u += 0x7fffu + ((u >> 16) & 1u);
  return (bf16_t)(u >> 16);
}
__device__ __forceinline__ float bf2f(bf16_t h) { return __uint_as_float(((unsigned)h) << 16); }

__device__ __forceinline__ unsigned cvt_pk_bf16(float lo, float hi) { unsigned r; asm volatile("v_cvt_pk_bf16_f32 %0, %1, %2" : "=v"(r) : "v"(lo), "v"(hi)); return r; }
__device__ __forceinline__ unsigned pack2(float a, float b) { return cvt_pk_bf16(a, b); }
__device__ __forceinline__ float silu_f(float x) { return x * __builtin_amdgcn_rcpf(1.f + __expf(-x)); }
__device__ __forceinline__ int swz(int row, int ch) { return row * 128 + ((ch ^ ((row >> 1) & 7)) << 4); }
__device__ __forceinline__ float2 cmul(float2 a, float2 b) { return make_float2(a.x * b.x - a.y * b.y, a.x * b.y + a.y * b.x); }
__device__ __forceinline__ float2 cexp_rev(float rev) { return make_float2(__builtin_amdgcn_cosf(rev), __builtin_amdgcn_sinf(rev)); }

enum { EPI_SWIGLU = 0, EPI_RESID = 1, EPI_QK = 2, EPI_T = 3, EPI_FILT = 4 };

struct Epi {
  float* S; const float* Sin; float* out2; const float* gate; const float* bias; float coef;
  bf16_t* ob; int ldo; int vmode; int atomic; float* part;
  bf16_t* q; bf16_t* kb; const float* qn; const float* kn;
};

__device__ __forceinline__ int swz32(int row, int ch) { return row * 64 + ((ch ^ ((0 - (row >> 2)) & 3)) << 4); }

template <int EPI>
__device__ __forceinline__ void gemm256_tile(const bf16_t* A, const bf16_t* Bt, int ld, int kt0, int nkt, int m0, int n0, char* lds, const Epi& e, int part) {
  const int tid = tid_(), lane = tid & 63, w = __builtin_amdgcn_readfirstlane(tid >> 6);
  const int wm = w >> 2, wn = w & 3;
  const int fr = lane & 15, fq = lane >> 4;
  f32x4 acc[8][4];
#pragma unroll
  for (int i = 0; i < 8; ++i)
#pragma unroll
    for (int j = 0; j < 4; ++j) acc[i][j] = (f32x4){0.f, 0.f, 0.f, 0.f};
  unsigned soff[2];
#pragma unroll
  for (int i = 0; i < 2; ++i) {
    const int r = 16 * (w * 2 + i) + (lane >> 2);
    const int c = (lane & 3) ^ ((0 - (r >> 2)) & 3);
    soff[i] = (unsigned)(r * ld + c * 8);
  }
  const int nks = nkt * 2;
  const bf16_t* Ab = A + (size_t)m0 * ld + (size_t)kt0 * 64;
  const bf16_t* Bb = Bt + (size_t)n0 * ld + (size_t)kt0 * 64;
  char* ldsw = lds + w * 2048;
#define G256_ISSUE(step)                                                                                                        \
  do {                                                                                                                          \
    const int st_ = (step) < nks ? (step) : (nks - 1);                                                                          \
    char* dA_ = ldsw + ((step) & 3) * 32768;                                                                                    \
    const bf16_t* ga_ = Ab + (size_t)st_ * 32;                                                                                  \
    const bf16_t* gb_ = Bb + (size_t)st_ * 32;                                                                                  \
    __builtin_amdgcn_global_load_lds((const unsigned*)(ga_ + soff[0]), (unsigned*)(dA_), 16, 0, 0);                             \
    __builtin_amdgcn_global_load_lds((const unsigned*)(ga_ + soff[1]), (unsigned*)(dA_ + 1024), 16, 0, 0);                      \
    __builtin_amdgcn_global_load_lds((const unsigned*)(gb_ + soff[0]), (unsigned*)(dA_ + 16384), 16, 0, 0);                     \
    __builtin_amdgcn_global_load_lds((const unsigned*)(gb_ + soff[1]), (unsigned*)(dA_ + 16384 + 1024), 16, 0, 0);              \
  } while (0)
#define G256_PIECE(step, q)                                                                                                      \
  do {                                                                                                                          \
    const int st_ = (step) < nks ? (step) : (nks - 1);                                                                          \
    char* dA_ = ldsw + ((step) & 3) * 32768 + (((q) >> 1) ? 16384 : 0) + (((q) & 1) ? 1024 : 0);                                 \
    const bf16_t* g_ = (((q) >> 1) ? Bb : Ab) + (size_t)st_ * 32 + soff[(q) & 1];                                               \
    __builtin_amdgcn_global_load_lds((const unsigned*)g_, (unsigned*)dA_, 16, 0, 0);                                            \
  } while (0)
  G256_ISSUE(0);
  G256_ISSUE(1);
  G256_ISSUE(2);
  for (int t = 0; t < nks; ++t) {
    asm volatile("s_waitcnt vmcnt(8) lgkmcnt(0)" ::: "memory");
    __builtin_amdgcn_s_barrier();
    asm volatile("" ::: "memory");
    const char* cA = lds + (t & 3) * 32768;
    const char* cB = cA + 16384;
    bf16x8 bfr[4];
#pragma unroll
    for (int ni = 0; ni < 4; ++ni) bfr[ni] = *(const bf16x8*)(cB + swz32(wn * 64 + ni * 16 + fr, fq));
#pragma unroll
    for (int mh = 0; mh < 2; ++mh) {
      bf16x8 af[4];
#pragma unroll
      for (int mi = 0; mi < 4; ++mi) af[mi] = *(const bf16x8*)(cA + swz32(wm * 128 + (mh * 4 + mi) * 16 + fr, fq));
#pragma unroll
      for (int mi = 0; mi < 4; ++mi) {
#pragma unroll
        for (int ni = 0; ni < 4; ++ni)
          acc[mh * 4 + mi][ni] = __builtin_amdgcn_mfma_f32_16x16x32_bf16(bfr[ni], af[mi], acc[mh * 4 + mi][ni], 0, 0, 0);
        if (mi == 1) G256_PIECE(t + 3, mh * 2 + 0);
        if (mi == 3) G256_PIECE(t + 3, mh * 2 + 1);
      }
    }
  }
  asm volatile("s_waitcnt vmcnt(0)" ::: "memory");
  __syncthreads();
#undef G256_ISSUE
#undef G256_PIECE
  const int rbase = m0 + wm * 128 + fr;
  const int cbase = n0 + wn * 64 + 4 * fq;
  if (EPI == EPI_SWIGLU) {
#pragma unroll
    for (int mi = 0; mi < 8; ++mi) {
      const int rl = wm * 128 + mi * 16 + fr;
#pragma unroll
      for (int nj = 0; nj < 2; ++nj) {
        const int fl = wn * 32 + nj * 16 + 4 * fq;
        const f32x4 g = acc[mi][2 * nj], u = acc[mi][2 * nj + 1];
        uint2 pk;
        pk.x = pack2(silu_f(g[0]) * u[0], silu_f(g[1]) * u[1]);
        pk.y = pack2(silu_f(g[2]) * u[2], silu_f(g[3]) * u[3]);
        *(uint2*)(lds + rl * 272 + fl * 2) = pk;
      }
    }
    __syncthreads();
    {
      bf16_t* dst = e.ob + (size_t)m0 * FF + (n0 >> 1);
#pragma unroll
      for (int i = 0; i < 8; ++i) {
        const int c = tid + 512 * i;
        const int rl = c >> 4, ch = c & 15;
        const uint4 v = *(const uint4*)(lds + rl * 272 + ch * 16);
        *(uint4*)(dst + (size_t)rl * FF + ch * 8) = v;
      }
    }
    __syncthreads();
  } else if (EPI == EPI_RESID) {
    const int grp = (m0 < SEQ) ? 0 : ((m0 < MLAT) ? 1 : 2);
#pragma unroll
    for (int ni = 0; ni < 4; ++ni) {
      const int col = cbase + ni * 16;
      float4 g = *(const float4*)(e.gate + grp * 9216 + col);
      g.x *= e.coef; g.y *= e.coef; g.z *= e.coef; g.w *= e.coef;
      float4 bv = make_float4(0.f, 0.f, 0.f, 0.f);
      if (e.bias && part == 0) bv = *(const float4*)(e.bias + col);
#pragma unroll
      for (int mi = 0; mi < 8; ++mi) {
        const int row = rbase + mi * 16;
        const size_t idx = (size_t)row * D + col;
        const f32x4 a = acc[mi][ni];
        if (e.atomic) {
          float4 o4;
          o4.x = g.x * (a[0] + bv.x); o4.y = g.y * (a[1] + bv.y); o4.z = g.z * (a[2] + bv.z); o4.w = g.w * (a[3] + bv.w);
          *(float4*)(e.part + ((size_t)part * 512 + (row - MLAT)) * D + col) = o4;
        } else {
          float4 s4 = *(const float4*)(e.Sin + idx);
          s4.x += g.x * (a[0] + bv.x); s4.y += g.y * (a[1] + bv.y); s4.z += g.z * (a[2] + bv.z); s4.w += g.w * (a[3] + bv.w);
          *(float4*)(e.S + idx) = s4;
          if (e.out2 && row < MLAT) *(float4*)(e.out2 + idx) = s4;
        }
      }
    }
  } else if (EPI == EPI_QK) {
    const int hcol0 = n0 + wn * 64;
    const bool isq = hcol0 < 1024;
    const float* nw = isq ? e.qn : e.kn;
    float4 nwv[4];
#pragma unroll
    for (int ni = 0; ni < 4; ++ni) nwv[ni] = *(const float4*)(nw + ni * 16 + 4 * fq);
    float freq[4];
#pragma unroll
    for (int i = 0; i < 4; ++i) freq[i] = exp2f(-(float)(4 * fq + i) * (13.287712379549449f / 16.f)) * 0.15915494309189535f;
    const float qs = isq ? (0.125f * 1.4426950408889634f) : 1.f;
#pragma unroll
    for (int mi = 0; mi < 8; ++mi) {
      const int row = rbase + mi * 16;
      f32x4 v[4];
      float ss = 0.f;
#pragma unroll
      for (int ni = 0; ni < 4; ++ni) { v[ni] = acc[mi][ni]; ss += v[ni][0] * v[ni][0] + v[ni][1] * v[ni][1] + v[ni][2] * v[ni][2] + v[ni][3] * v[ni][3]; }
      ss += __shfl_xor(ss, 16); ss += __shfl_xor(ss, 32);
      const float rstd = rsqrtf(ss * (1.f / 64.f) + EPSN);
#pragma unroll
      for (int ni = 0; ni < 4; ++ni) {
        v[ni][0] *= rstd * nwv[ni].x; v[ni][1] *= rstd * nwv[ni].y; v[ni][2] *= rstd * nwv[ni].z; v[ni][3] *= rstd * nwv[ni].w;
      }
      if (row < MLAT) {
        const int t = row & (SEQ - 1);
        const float pr = (float)(t >> 6), pc = (float)(t & 63);
#pragma unroll
        for (int i = 0; i < 4; ++i) {
          const float ar = pr * freq[i], ac = pc * freq[i];
          const float cr = __builtin_amdgcn_cosf(ar), sr = __builtin_amdgcn_sinf(ar);
          const float cc = __builtin_amdgcn_cosf(ac), sc = __builtin_amdgcn_sinf(ac);
          const float a0 = v[0][i] * cr - v[1][i] * sr, a1 = v[0][i] * sr + v[1][i] * cr;
          const float a2 = v[2][i] * cc - v[3][i] * sc, a3 = v[2][i] * sc + v[3][i] * cc;
          v[0][i] = a0; v[1][i] = a1; v[2][i] = a2; v[3][i] = a3;
        }
      }
      bf16_t* dst;
      if (isq) dst = e.q + (size_t)row * D + hcol0 + 4 * fq;
      else {
        const int kvh = (hcol0 - 1024) >> 6;
        int b, pos;
        if (row < MLAT) { b = row >> 13; pos = CTXL + (row & (SEQ - 1)); }
        else { b = (row - MLAT) >> 8; pos = (row - MLAT) & 255; }
        dst = e.kb + ((size_t)(b * 4 + kvh) * NKEY + pos) * 64 + 4 * fq;
      }
#pragma unroll
      for (int ni = 0; ni < 4; ++ni) {
        uint2 pk;
        pk.x = pack2(v[ni][0] * qs, v[ni][1] * qs);
        pk.y = pack2(v[ni][2] * qs, v[ni][3] * qs);
        *(uint2*)(dst + ni * 16) = pk;
      }
    }
  } else if (EPI == EPI_T) {
#pragma unroll
    for (int ni = 0; ni < 4; ++ni) {
      const int tok = cbase + ni * 16;
      size_t cm = (size_t)tok;
      if (e.vmode) {
        int b, pos;
        if (tok < MLAT) { b = tok >> 13; pos = CTXL + (tok & (SEQ - 1)); }
        else { b = (tok - MLAT) >> 8; pos = (tok - MLAT) & 255; }
        cm = (size_t)b * 256 * NKEY + pos;
      }
#pragma unroll
      for (int mi = 0; mi < 8; ++mi) {
        const int row = rbase + mi * 16;
        const float bv = e.bias ? e.bias[row] : 0.f;
        const f32x4 a = acc[mi][ni];
        uint2 pk;
        pk.x = pack2(a[0] + bv, a[1] + bv);
        pk.y = pack2(a[2] + bv, a[3] + bv);
        *(uint2*)(e.ob + (size_t)row * e.ldo + cm) = pk;
      }
    }
  } else if (EPI == EPI_FILT) {
#pragma unroll
    for (int mi = 0; mi < 8; ++mi) {
      const int row = rbase + mi * 16;
      const int d = row & 1023;
      const float delta = fabsf(-3.0701134573253945f + (float)d * ((-15.350567286626973f + 3.0701134573253945f) / 1023.f));
      const float dk = -delta * (1.f / 8191.f);
#pragma unroll
      for (int ni = 0; ni < 4; ++ni) {
        const int t = cbase + ni * 16;
        const f32x4 a = acc[mi][ni];
        uint2 pk;
        pk.x = pack2(a[0] * __expf((float)t * dk), a[1] * __expf((float)(t + 1) * dk));
        pk.y = pack2(a[2] * __expf((float)(t + 2) * dk), a[3] * __expf((float)(t + 3) * dk));
        *(uint2*)(e.ob + (size_t)row * SEQ + t) = pk;
      }
    }
  }
}

template <int EPI>
__device__ __forceinline__ void gemm256_phase(const bf16_t* A, const bf16_t* Bt, int ld, int nkt, int MT, int NTn, char* lds, const Epi& e, int rot) {
  const int G = gridDim.x;
  const int total = MT * NTn;
  int bid = (int)((blockIdx.x + G - (rot % G)) % G);
  if ((G & 7) == 0) bid = (bid & 7) * (G >> 3) + (bid >> 3);
  for (int u = bid; u < total; u += G) {
    const int band = u / (8 * NTn);
    const int rem = u - band * 8 * NTn;
    const int gsz = min(8, MT - band * 8);
    const int nt = rem / gsz, mt = band * 8 + (rem - nt * gsz);
    gemm256_tile<EPI>(A, Bt, ld, 0, nkt, mt * 256, nt * 256, lds, e, 0);
  }
}

__device__ __forceinline__ void convert_matrix(const float* src, int K, int N, bf16_t* dst, int perm, char* lds, int& rot) {
  const int G = gridDim.x, tid = tid_();
  const int tn = N >> 8, tk = K >> 6, total = tn * tk;
  bf16_t* T = (bf16_t*)lds;
  const int kr0 = tid >> 6, c4 = tid & 63;
  int t = (int)((blockIdx.x + G - (rot % G)) % G);
  float4 v[8];
  if (t < total) {
    const int kt = t / tn, ntile = t - kt * tn;
    const float* g = src + (size_t)((kt << 6) + kr0) * N + (ntile << 8) + c4 * 4;
#pragma unroll
    for (int i = 0; i < 8; ++i) v[i] = *(const float4*)(g + (size_t)(8 * i) * N);
  }
  for (; t < total; t += G) {
    const int kt = t / tn, ntile = t - kt * tn;
    const int k0 = kt << 6, n0 = ntile << 8;
#pragma unroll
    for (int i = 0; i < 8; ++i) {
      const int kr = kr0 + 8 * i;
      T[(c4 * 4 + 0) * 72 + kr] = f2bf(v[i].x);
      T[(c4 * 4 + 1) * 72 + kr] = f2bf(v[i].y);
      T[(c4 * 4 + 2) * 72 + kr] = f2bf(v[i].z);
      T[(c4 * 4 + 3) * 72 + kr] = f2bf(v[i].w);
    }
    const int t2 = t + G;
    if (t2 < total) {
      const int kt2 = t2 / tn, nt2 = t2 - kt2 * tn;
      const float* g = src + (size_t)((kt2 << 6) + kr0) * N + (nt2 << 8) + c4 * 4;
#pragma unroll
      for (int i = 0; i < 8; ++i) v[i] = *(const float4*)(g + (size_t)(8 * i) * N);
    }
    __syncthreads();
#pragma unroll
    for (int i = 0; i < 4; ++i) {
      const int idx = tid + 512 * i;
      const int n = idx >> 3, ch = idx & 7;
      const uint4 o = *(const uint4*)(T + n * 72 + ch * 8);
      int ng = n0 + n;
      if (perm) {
        if (ng < FF) ng = ((ng >> 4) << 5) + (ng & 15);
        else { const int f = ng - FF; ng = ((f >> 4) << 5) + 16 + (f & 15); }
      }
      *(uint4*)(dst + (size_t)ng * K + k0 + ch * 8) = o;
    }
    __syncthreads();
  }
  rot += total;
}

__device__ __forceinline__ void p0_prologue(const Params& p, char* lds) {
  const int G = gridDim.x, tid = tid_(), lane = tid & 63, w = tid >> 6;
  char* ws = p.ws;
  {
    float4* S4 = (float4*)(ws + OFF_S);
    const float4* x4 = (const float4*)p.in[0];
    const float4* c4 = (const float4*)p.in[2];
    const size_t nlat = (size_t)MLAT * D / 4, nall = (size_t)MALL * D / 4;
    (void)x4;
    for (size_t i = nlat + (size_t)blockIdx.x * NTHR + tid; i < nall; i += (size_t)G * NTHR)
      S4[i] = c4[i - nlat];
  }
  {
    float* MOD = (float*)(ws + OFF_MOD);
    const float* c = p.in[1];
    const float* cc = p.in[3];
    float* red = (float*)lds;
    for (int it = blockIdx.x; it < 4 * 144; it += G) {
      const int l = it / 144, c0 = (it - l * 144) * 64;
      const int cg4 = lane & 15, kq = lane >> 4;
      float a[3][4];
#pragma unroll
      for (int g = 0; g < 3; ++g)
#pragma unroll
        for (int j = 0; j < 4; ++j) a[g][j] = 0.f;
      const float* wb = p.in[4] + (size_t)l * D * 9216 + c0 + cg4 * 4;
#pragma unroll 4
      for (int i = 0; i < 32; ++i) {
        const int k = w * 128 + i * 4 + kq;
        const float4 wv = *(const float4*)(wb + (size_t)k * 9216);
        const float s0 = silu_f(c[k]), s1 = silu_f(c[D + k]), s2 = silu_f(cc[k]);
        a[0][0] += s0 * wv.x; a[0][1] += s0 * wv.y; a[0][2] += s0 * wv.z; a[0][3] += s0 * wv.w;
        a[1][0] += s1 * wv.x; a[1][1] += s1 * wv.y; a[1][2] += s1 * wv.z; a[1][3] += s1 * wv.w;
        a[2][0] += s2 * wv.x; a[2][1] += s2 * wv.y; a[2][2] += s2 * wv.z; a[2][3] += s2 * wv.w;
      }
#pragma unroll
      for (int g = 0; g < 3; ++g)
#pragma unroll
        for (int j = 0; j < 4; ++j) {
          float v = a[g][j];
          v += __shfl_xor(v, 16); v += __shfl_xor(v, 32);
          a[g][j] = v;
        }
      if (kq == 0) {
#pragma unroll
        for (int g = 0; g < 3; ++g)
#pragma unroll
          for (int j = 0; j < 4; ++j) red[(w * 3 + g) * 64 + cg4 * 4 + j] = a[g][j];
      }
      __syncthreads();
      if (tid < 192) {
        const int g = tid >> 6, col = tid & 63;
        float s = 0.f;
#pragma unroll
        for (int ww = 0; ww < 8; ++ww) s += red[(ww * 3 + g) * 64 + col];
        MOD[(size_t)(l * 3 + g) * 9216 + c0 + col] = s + p.in[5][(size_t)l * 9216 + c0 + col];
      }
      __syncthreads();
    }
  }
  {
    int rot = 0;
    for (int i = 0; i < 8; ++i) convert_matrix(p.in[7] + (size_t)i * D * NGU, D, NGU, (bf16_t*)(ws + OFF_WGU) + (size_t)i * NGU * D, 1, lds, rot);
    for (int i = 0; i < 8; ++i) convert_matrix(p.in[8] + (size_t)i * FF * D, FF, D, (bf16_t*)(ws + OFF_WD) + (size_t)i * D * FF, 0, lds, rot);
    for (int i = 0; i < 2; ++i) convert_matrix(p.in[9] + (size_t)i * D * 1536, D, 1536, (bf16_t*)(ws + OFF_WQKV) + (size_t)i * 1536 * D, 0, lds, rot);
    for (int i = 0; i < 2; ++i) convert_matrix(p.in[10] + (size_t)i * D * D, D, D, (bf16_t*)(ws + OFF_WO) + (size_t)i * D * D, 0, lds, rot);
    for (int i = 0; i < 2; ++i) convert_matrix(p.in[13] + (size_t)i * D * 3072, D, 3072, (bf16_t*)(ws + OFF_WIN) + (size_t)i * 3072 * D, 0, lds, rot);
    for (int i = 0; i < 2; ++i) convert_matrix(p.in[26] + (size_t)i * D * D, D, D, (bf16_t*)(ws + OFF_WHO) + (size_t)i * D * D, 0, lds, rot);
    for (int i = 0; i < 2; ++i) convert_matrix(p.in[23] + (size_t)i * 64 * 4096, 64, 4096, (bf16_t*)(ws + OFF_WOUTT) + (size_t)i * 4096 * 64, 0, lds, rot);
  }
  {
    float* W1 = (float*)lds;
    float* W2 = W1 + 33 * 64;
    float* W3 = W2 + 64 * 64;
    float* feat = W3 + 64 * 64;
    float* h1 = feat + 8 * 40;
    float* h2 = h1 + 8 * 64;
    const int tt = tid >> 6, h = tid & 63;
    const int per = 256 + 8;
    int jcur = -1;
    for (int it = blockIdx.x; it < 2 * per; it += G) {
      const int j = it / per;
      int r = it - j * per;
      const int Lsel = (r >= 256);
      if (Lsel) r -= 256;
      const int L = Lsel ? 256 : 8192;
      if (j != jcur) {
        __syncthreads();
        for (int i = tid; i < 33 * 64; i += NTHR) W1[i] = p.in[17][(size_t)j * 33 * 64 + i];
        for (int i = tid; i < 64 * 64; i += NTHR) { W2[i] = p.in[19][(size_t)j * 4096 + i]; W3[i] = p.in[21][(size_t)j * 4096 + i]; }
        jcur = j;
        __syncthreads();
      }
      const float a = p.in[24][j * 64 + h];
      const float b1 = p.in[18][j * 64 + h], b2 = p.in[20][j * 64 + h], b3 = p.in[22][j * 64 + h];
      for (int sub = 0; sub < 4; ++sub) {
        const int t = r * 32 + sub * 8 + tt;
        if (h < 33) {
          const float tl = (float)t / (float)(L - 1);
          const float wv = (6.2831855f * (float)t) / (float)L;
          float f;
          if (h == 0) f = tl;
          else {
            const int bi = (h - 1) & 15;
            const float band = 1e-4f + (float)bi * ((15.f - 1e-4f) / 15.f);
            const float ang = band * wv;
            f = (h <= 16) ? __cosf(ang) : -__sinf(ang);
          }
          feat[tt * 40 + h] = f;
        }
        __syncthreads();
        {
          float s = b1;
#pragma unroll
          for (int e2 = 0; e2 < 33; ++e2) s += feat[tt * 40 + e2] * W1[e2 * 64 + h];
          h1[tt * 64 + h] = __sinf(a * s);
        }
        __syncthreads();
        {
          float s = b2;
#pragma unroll 16
          for (int k = 0; k < 64; ++k) s += h1[tt * 64 + k] * W2[k * 64 + h];
          h2[tt * 64 + h] = __sinf(a * s);
        }
        __syncthreads();
        {
          float s = b3;
#pragma unroll 16
          for (int k = 0; k < 64; ++k) s += h2[tt * 64 + k] * W3[k * 64 + h];
          const float v = __sinf(a * s);
          if (Lsel) ((float*)(ws + OFF_HID3C))[((size_t)j * 256 + t) * 64 + h] = v;
          else ((bf16_t*)(ws + OFF_HID3))[((size_t)j * 8192 + t) * 64 + h] = f2bf(v);
        }
      }
    }
    __syncthreads();
  }
}

__device__ __forceinline__ void normmod_phase(const Params& p, int l, int k, int rows, int nparts) {
  const int G = gridDim.x, tid = tid_(), lane = tid & 63, w = tid >> 6;
  float* S = (float*)(p.ws + OFF_S);
  const float* PART = (const float*)(p.ws + OFF_PART);
  bf16_t* HB = (bf16_t*)(p.ws + OFF_HB);
  const float* MOD = (const float*)(p.ws + OFF_MOD) + (size_t)l * 3 * 9216;
  const float* nw = p.in[6] + (size_t)(l * 3 + k) * D;
  const int stride = G * 8;
  for (int row0 = blockIdx.x * 8 + w; row0 < rows; row0 += 2 * stride) {
    float4 x[2][4];
    float ss[2] = {0.f, 0.f};
#pragma unroll
    for (int rr = 0; rr < 2; ++rr) {
      const int row = row0 + rr * stride;
      if (row < rows) {
#pragma unroll
        for (int q = 0; q < 4; ++q) x[rr][q] = *(const float4*)(((l == 0 && k == 0 && row < MLAT) ? p.in[0] : (const float*)S) + (size_t)row * D + q * 256 + lane * 4);
      } else {
#pragma unroll
        for (int q = 0; q < 4; ++q) x[rr][q] = make_float4(0.f, 0.f, 0.f, 0.f);
      }
    }
#pragma unroll
    for (int rr = 0; rr < 2; ++rr) {
      const int row = row0 + rr * stride;
      if (row < rows && row >= MLAT && nparts > 0) {
#pragma unroll
        for (int q = 0; q < 4; ++q) {
          for (int pp = 0; pp < nparts; ++pp) {
            const float4 t4 = *(const float4*)(PART + ((size_t)pp * 512 + (row - MLAT)) * D + q * 256 + lane * 4);
            x[rr][q].x += t4.x; x[rr][q].y += t4.y; x[rr][q].z += t4.z; x[rr][q].w += t4.w;
          }
          *(float4*)(S + (size_t)row * D + q * 256 + lane * 4) = x[rr][q];
        }
      }
#pragma unroll
      for (int q = 0; q < 4; ++q) ss[rr] += x[rr][q].x * x[rr][q].x + x[rr][q].y * x[rr][q].y + x[rr][q].z * x[rr][q].z + x[rr][q].w * x[rr][q].w;
    }
#pragma unroll
    for (int o = 1; o < 64; o <<= 1) { ss[0] += __shfl_xor(ss[0], o); ss[1] += __shfl_xor(ss[1], o); }
#pragma unroll
    for (int rr = 0; rr < 2; ++rr) {
      const int row = row0 + rr * stride;
      if (row < rows) {
        const int grp = (row < SEQ) ? 0 : ((row < MLAT) ? 1 : 2);
        const float* sh = MOD + grp * 9216 + (3 * k) * D;
        const float* sc = sh + D;
        const float rstd = rsqrtf(ss[rr] * (1.f / 1024.f) + EPSN);
#pragma unroll
        for (int q = 0; q < 4; ++q) {
          const int c = q * 256 + lane * 4;
          const float4 g = *(const float4*)(nw + c);
          const float4 s1 = *(const float4*)(sc + c);
          const float4 s0 = *(const float4*)(sh + c);
          uint2 pk;
          pk.x = pack2(x[rr][q].x * rstd * g.x * (1.f + s1.x) + s0.x, x[rr][q].y * rstd * g.y * (1.f + s1.y) + s0.y);
          pk.y = pack2(x[rr][q].z * rstd * g.z * (1.f + s1.z) + s0.z, x[rr][q].w * rstd * g.w * (1.f + s1.w) + s0.w);
          *(uint2*)(HB + (size_t)row * D + c) = pk;
        }
      }
    }
  }
}

__device__ __forceinline__ void attention_phase(const Params& p, int ai, char* lds) {
  const int G = gridDim.x, tid = tid_(), lane = tid & 63, w = tid >> 6;
  const int l31 = lane & 31, hh = lane >> 5;
  const bf16_t* Q = (const bf16_t*)(p.ws + OFF_Q);
  const bf16_t* KB = (const bf16_t*)(p.ws + OFF_KB);
  const bf16_t* VT = (const bf16_t*)(p.ws + OFF_VT);
  bf16_t* OB = (bf16_t*)(p.ws + OFF_OB);
  const int lrow = tid >> 3, lch = tid & 7;
  float sbound;
  {
    float mq = fabsf(p.in[11][ai * 64 + lane]), mk = fabsf(p.in[12][ai * 64 + lane]);
#pragma unroll
    for (int o = 1; o < 64; o <<= 1) { mq = fmaxf(mq, __shfl_xor(mq, o)); mk = fmaxf(mk, __shfl_xor(mk, o)); }
    sbound = fminf(8.f * mq * mk * 1.4426950408889634f, 100.f);
  }
  for (int it = blockIdx.x; it < 1024 + 32; it += G) {
    int b, head, rowbase, nT;
    if (it < 1024) { b = it >> 9; head = (it >> 5) & 15; rowbase = b * SEQ + (it & 31) * 256; nT = NKEY / 64; }
    else { const int r = it - 1024; b = r >> 4; head = r & 15; rowbase = MLAT + b * CTXL; nT = CTXL / 64; }
    const int kvh = head >> 2;
    const bf16_t* kp = KB + ((size_t)(b * 4 + kvh) * NKEY + lrow) * 64 + lch * 8;
    const bf16_t* vp = VT + ((size_t)(b * 4 + kvh) * 64 + lrow) * NKEY + lch * 8;
    bf16x8 qf[4];
    {
      const bf16_t* qp = Q + (size_t)(rowbase + w * 32 + l31) * D + head * 64 + hh * 8;
#pragma unroll
      for (int ks = 0; ks < 4; ++ks) qf[ks] = *(const bf16x8*)(qp + ks * 16);
    }
    f32x16 o0, o1;
#pragma unroll
    for (int i = 0; i < 16; ++i) { o0[i] = 0.f; o1[i] = 0.f; }
    f32x16 negm;
#pragma unroll
    for (int i = 0; i < 16; ++i) negm[i] = -sbound;
    float lsa = 0.f, lsb = 0.f;
    uint4 rk = *(const uint4*)(kp);
    uint4 rv = *(const uint4*)(vp);
    *(uint4*)(lds + swz(lrow, lch)) = rk;
    *(uint2*)(lds + 16384 + lrow * 136 + lch * 16) = make_uint2(rv.x, rv.y);
    *(uint2*)(lds + 16384 + lrow * 136 + lch * 16 + 8) = make_uint2(rv.z, rv.w);
    __syncthreads();
    for (int kt = 0; kt < nT; ++kt) {
      char* cK = lds + (kt & 1) * 8192;
      char* cV = lds + 16384 + (kt & 1) * 8704;
      const bool more = (kt + 1 < nT);
      if (more) {
        rk = *(const uint4*)(kp + (size_t)(kt + 1) * 64 * 64);
        rv = *(const uint4*)(vp + (kt + 1) * 64);
      }
      f32x16 s0, s1;
      {
        const bf16x8 a0 = *(const bf16x8*)(cK + swz(l31, hh));
        const bf16x8 a1 = *(const bf16x8*)(cK + swz(l31 + 32, hh));
        s0 = __builtin_amdgcn_mfma_f32_32x32x16_bf16(a0, qf[0], negm, 0, 0, 0);
        s1 = __builtin_amdgcn_mfma_f32_32x32x16_bf16(a1, qf[0], negm, 0, 0, 0);
      }
#pragma unroll
      for (int ks = 1; ks < 4; ++ks) {
        const bf16x8 a0 = *(const bf16x8*)(cK + swz(l31, 2 * ks + hh));
        const bf16x8 a1 = *(const bf16x8*)(cK + swz(l31 + 32, 2 * ks + hh));
        s0 = __builtin_amdgcn_mfma_f32_32x32x16_bf16(a0, qf[ks], s0, 0, 0, 0);
        s1 = __builtin_amdgcn_mfma_f32_32x32x16_bf16(a1, qf[ks], s1, 0, 0, 0);
      }
#pragma unroll
      for (int i = 0; i < 16; i += 2) {
        s0[i] = __builtin_amdgcn_exp2f(s0[i]); s0[i + 1] = __builtin_amdgcn_exp2f(s0[i + 1]);
        s1[i] = __builtin_amdgcn_exp2f(s1[i]); s1[i + 1] = __builtin_amdgcn_exp2f(s1[i + 1]);
        lsa += s0[i] + s1[i];
        lsb += s0[i + 1] + s1[i + 1];
      }
      bf16x8 pf[4];
#pragma unroll
      for (int j = 0; j < 4; ++j) {
        u32x4 cv;
#pragma unroll
        for (int q2 = 0; q2 < 4; ++q2) {
          const int i0 = 8 * (j & 1) + 2 * q2;
          const float x0 = (j < 2) ? s0[i0] : s1[i0];
          const float x1 = (j < 2) ? s0[i0 + 1] : s1[i0 + 1];
          cv[q2] = cvt_pk_bf16(x0, x1);
        }
        pf[j] = __builtin_bit_cast(bf16x8, cv);
      }
#pragma unroll
      for (int j = 0; j < 4; ++j) {
        const char* r0 = cV + l31 * 136 + j * 32 + hh * 8;
        const char* r1 = cV + (l31 + 32) * 136 + j * 32 + hh * 8;
        const uint2 x0 = *(const uint2*)(r0), x1 = *(const uint2*)(r0 + 16);
        const uint2 y0 = *(const uint2*)(r1), y1 = *(const uint2*)(r1 + 16);
        const u32x4 v0 = {x0.x, x0.y, x1.x, x1.y};
        const u32x4 v1 = {y0.x, y0.y, y1.x, y1.y};
        o0 = __builtin_amdgcn_mfma_f32_32x32x16_bf16(__builtin_bit_cast(bf16x8, v0), pf[j], o0, 0, 0, 0);
        o1 = __builtin_amdgcn_mfma_f32_32x32x16_bf16(__builtin_bit_cast(bf16x8, v1), pf[j], o1, 0, 0, 0);
      }
      if (more) {
        char* nK = lds + ((kt + 1) & 1) * 8192;
        char* nV = lds + 16384 + ((kt + 1) & 1) * 8704;
        *(uint4*)(nK + swz(lrow, lch)) = rk;
        *(uint2*)(nV + lrow * 136 + lch * 16) = make_uint2(rv.x, rv.y);
        *(uint2*)(nV + lrow * 136 + lch * 16 + 8) = make_uint2(rv.z, rv.w);
      }
      __syncthreads();
    }
    float lsum = lsa + lsb;
    lsum += __shfl_xor(lsum, 32);
    const float inv = 1.f / lsum;
    bf16_t* op = OB + (size_t)(rowbase + w * 32 + l31) * D + head * 64 + hh * 4;
#pragma unroll
    for (int g4 = 0; g4 < 4; ++g4) {
      uint2 pk;
      pk.x = pack2(o0[g4 * 4 + 0] * inv, o0[g4 * 4 + 1] * inv);
      pk.y = pack2(o0[g4 * 4 + 2] * inv, o0[g4 * 4 + 3] * inv);
      *(uint2*)(op + g4 * 8) = pk;
      pk.x = pack2(o1[g4 * 4 + 0] * inv, o1[g4 * 4 + 1] * inv);
      pk.y = pack2(o1[g4 * 4 + 2] * inv, o1[g4 * 4 + 3] * inv);
      *(uint2*)(op + 32 + g4 * 8) = pk;
    }
  }
}

__device__ __forceinline__ void dft16(float2 (&v)[16]) {
  float2 t[4][4];
#pragma unroll
  for (int a = 0; a < 4; ++a) {
    const float2 x0 = v[a], x1 = v[a + 4], x2 = v[a + 8], x3 = v[a + 12];
    const float2 s0 = make_float2(x0.x + x2.x, x0.y + x2.y), s1 = make_float2(x0.x - x2.x, x0.y - x2.y);
    const float2 s2 = make_float2(x1.x + x3.x, x1.y + x3.y), s3 = make_float2(x1.x - x3.x, x1.y - x3.y);
    t[a][0] = make_float2(s0.x + s2.x, s0.y + s2.y);
    t[a][1] = make_float2(s1.x + s3.y, s1.y - s3.x);
    t[a][2] = make_float2(s0.x - s2.x, s0.y - s2.y);
    t[a][3] = make_float2(s1.x - s3.y, s1.y + s3.x);
  }
  const float C1 = 0.92387953251128674f, S1 = 0.38268343236508977f, R2 = 0.70710678118654752f;
  t[1][1] = cmul(t[1][1], make_float2(C1, -S1));
  t[1][2] = cmul(t[1][2], make_float2(R2, -R2));
  t[1][3] = cmul(t[1][3], make_float2(S1, -C1));
  t[2][1] = cmul(t[2][1], make_float2(R2, -R2));
  t[2][2] = make_float2(t[2][2].y, -t[2][2].x);
  t[2][3] = cmul(t[2][3], make_float2(-R2, -R2));
  t[3][1] = cmul(t[3][1], make_float2(S1, -C1));
  t[3][2] = cmul(t[3][2], make_float2(-R2, -R2));
  t[3][3] = cmul(t[3][3], make_float2(-C1, S1));
#pragma unroll
  for (int c = 0; c < 4; ++c) {
    const float2 x0 = t[0][c], x1 = t[1][c], x2 = t[2][c], x3 = t[3][c];
    const float2 s0 = make_float2(x0.x + x2.x, x0.y + x2.y), s1 = make_float2(x0.x - x2.x, x0.y - x2.y);
    const float2 s2 = make_float2(x1.x + x3.x, x1.y + x3.y), s3 = make_float2(x1.x - x3.x, x1.y - x3.y);
    v[c] = make_float2(s0.x + s2.x, s0.y + s2.y);
    v[c + 4] = make_float2(s1.x + s3.y, s1.y - s3.x);
    v[c + 8] = make_float2(s0.x - s2.x, s0.y - s2.y);
    v[c + 12] = make_float2(s1.x - s3.y, s1.y + s3.x);
  }
}

__device__ __forceinline__ void r16_pass(float2 (&r)[16], float2* buf, int tid, int Ns) {
  const int k = tid & (Ns - 1);
  if (Ns > 1) {
    const float2 w1 = cexp_rev(-(float)k / (float)(16 * Ns));
    float2 w = w1;
#pragma unroll
    for (int i = 1; i < 16; ++i) {
      r[i] = cmul(r[i], w);
      w = cmul(w, w1);
    }
  }
  dft16(r);
  const int j0 = ((tid - k) << 4) + k;
#pragma unroll
  for (int m = 0; m < 16; ++m) { const int ix = j0 + m * Ns; buf[ix + (ix >> 4)] = r[m]; }
}

__device__ __forceinline__ void fft8192(float2 (&r)[16], float2* buf, int tid) {
#pragma unroll
  for (int Ns = 1; Ns < 4096; Ns <<= 4) {
    r16_pass(r, buf, tid, Ns);
    __syncthreads();
#pragma unroll
    for (int i = 0; i < 16; ++i) { const int ix = tid + 512 * i; r[i] = buf[ix + (ix >> 4)]; }
    __syncthreads();
  }
#pragma unroll
  for (int b = 0; b < 8; ++b) {
    const int j = tid + 512 * b;
    const float2 a0 = r[b];
    const float2 a1 = cmul(r[b + 8], cexp_rev(-(float)j * (1.f / 8192.f)));
    r[b] = make_float2(a0.x + a1.x, a0.y + a1.y);
    r[b + 8] = make_float2(a0.x - a1.x, a0.y - a1.y);
  }
}

__device__ __forceinline__ void stage_rows(const bf16_t* r0, const bf16_t* r1, char* dst, int tid) {
#pragma unroll
  for (int i = 0; i < 4; ++i) {
    const int c = tid + 512 * i;
    const bf16_t* src = (c < 1024) ? (r0 + c * 8) : (r1 + (c - 1024) * 8);
    *(uint4*)(dst + c * 16) = *(const uint4*)src;
  }
}

__device__ __forceinline__ void hyena_conv_phase(const Params& p, int j, bool with_ctx, char* lds) {
  const int G = gridDim.x, tid = tid_();
  const bf16_t* U = (const bf16_t*)(p.ws + OFF_ACT);
  const bf16_t* FILT = (const bf16_t*)(p.ws + OFF_FILT);
  bf16_t* YT = (bf16_t*)(p.ws + OFF_YT);
  const float* cw = p.in[15] + (size_t)j * 3 * 3072;
  const float* cb = p.in[16] + (size_t)j * 3072;
  const float* fbias = p.in[25] + (size_t)j * 2 * D;
  float2* buf0 = (float2*)lds;
  float2* bufH = buf0 + 8704;
  const int nitems = with_ctx ? 2048 : 1024;
  for (int it = blockIdx.x; it < nitems; it += G) {
    if (it < 1024) {
      const int d = it;
      float2 acc[16], r[16], xr[16];
      unsigned* zE = (unsigned*)bufH;
      unsigned* zO = zE + 8192;
#pragma unroll 1
      for (int part = 0; part < 2; ++part) {
        int tq = threadIdx.x;
        asm volatile("" : "+v"(tq));
        stage_rows(FILT + (size_t)(0 * 1024 + d) * SEQ, FILT + (size_t)(1 * 1024 + d) * SEQ, lds, tq);
        stage_rows(FILT + (size_t)(2 * 1024 + d) * SEQ, FILT + (size_t)(3 * 1024 + d) * SEQ, lds + 32768, tq);
        __syncthreads();
        const bf16_t* st = (const bf16_t*)lds;
#pragma unroll
        for (int i = 0; i < 16; ++i) {
          const int n = tq + 512 * i;
          const int nb = (n == 0) ? 0 : (SEQ - n);
          const float f0 = bf2f(st[n]), g0 = bf2f(st[SEQ + nb]);
          const float f1 = bf2f(st[2 * SEQ + n]), g1 = bf2f(st[3 * SEQ + nb]);
          if (part == 0) r[i] = make_float2(f0 + g0, f1 + g1);
          else {
            const float d0 = (n == 0) ? (f0 + g0) : (f0 - g0);
            const float d1 = (n == 0) ? (f1 + g1) : (f1 - g1);
            r[i] = cmul(make_float2(d0, d1), cexp_rev(-(float)n * (1.f / 16384.f)));
          }
        }
        __syncthreads();
        fft8192(r, buf0, tq);
        unsigned* zz = part ? zO : zE;
#pragma unroll
        for (int i = 0; i < 16; ++i) zz[tq + 512 * i] = pack2(r[i].x, r[i].y);
      }
      __syncthreads();
      {
        int t0 = threadIdx.x;
        asm volatile("" : "+v"(t0));
        const bf16_t* u0 = U + (size_t)d * MALL;
        stage_rows(u0, u0 + SEQ, lds, t0);
        __syncthreads();
        const bf16_t* st = (const bf16_t*)lds;
        const float w0 = cw[d], w1 = cw[3072 + d], w2 = cw[6144 + d], bb = cb[d];
#pragma unroll
        for (int i = 0; i < 16; ++i) {
          const int n = t0 + 512 * i;
          float vv[2];
#pragma unroll
          for (int b = 0; b < 2; ++b) {
            const bf16_t* ub = st + b * SEQ + n;
            const float um0 = bf2f(ub[(n > 0) ? -1 : 0]);
            const float uc = bf2f(ub[0]);
            const float up0 = bf2f(ub[(n < SEQ - 1) ? 1 : 0]);
            const float um = (n > 0) ? um0 : 0.f;
            const float up = (n < SEQ - 1) ? up0 : 0.f;
            vv[b] = um * w0 + uc * w1 + up * w2 + bb;
          }
          xr[i] = make_float2(vv[0], vv[1]);
        }
        __syncthreads();
      }
#pragma unroll 1
      for (int o = 0; o < 2; ++o) {
#pragma unroll 1
        for (int step = 1; step < 6; ++step) {
          if (step == 3) continue;
          int tq = threadIdx.x;
          asm volatile("" : "+v"(tq));
          if (step == 1) {
#pragma unroll
            for (int i = 0; i < 16; ++i) r[i] = xr[i];
          } else if (step == 4) {
#pragma unroll
            for (int i = 0; i < 16; ++i) {
              const int n = tq + 512 * i;
              r[i] = cmul(xr[i], cexp_rev(-(float)n * (1.f / 16384.f)));
            }
          }
          fft8192(r, buf0, tq);
          if (step == 1 || step == 4) {
            const unsigned* zz = (step == 1) ? zE : zO;
#pragma unroll
            for (int i = 0; i < 16; ++i) {
              const int k = tq + 512 * i;
              const int km = (step == 1) ? ((SEQ - k) & (SEQ - 1)) : (SEQ - 1 - k);
              const unsigned za = zz[k], zb = zz[km];
              const float2 Z = make_float2(__uint_as_float(za << 16), __uint_as_float(za & 0xffff0000u));
              const float2 Zm = make_float2(__uint_as_float(zb << 16), -__uint_as_float(zb & 0xffff0000u));
              float2 H;
              if (o == 0) H = make_float2(0.5f * (Z.x + Zm.x), 0.5f * (Z.y + Zm.y));
              else H = make_float2(0.5f * (Z.y - Zm.y), -0.5f * (Z.x - Zm.x));
              const float2 y = cmul(r[i], H);
              r[i] = make_float2(y.x, -y.y);
            }
          } else if (step == 2) {
#pragma unroll
            for (int i = 0; i < 16; ++i) acc[i] = make_float2(r[i].x, -r[i].y);
          } else {
#pragma unroll
            for (int i = 0; i < 16; ++i) {
              const int n = tq + 512 * i;
              const float2 wc = cexp_rev((float)n * (1.f / 16384.f));
              const float2 io = make_float2(r[i].x, -r[i].y);
              const float2 y = cmul(wc, io);
              acc[i] = make_float2((acc[i].x + y.x) * (1.f / 16384.f), (acc[i].y + y.y) * (1.f / 16384.f));
            }
          }
        }
        const int gc = (o == 0) ? (1024 + d) : (2048 + d);
        const bf16_t* ug = U + (size_t)gc * MALL;
        const float w0 = cw[gc], w1 = cw[3072 + gc], w2 = cw[6144 + gc], bb = cb[gc];
        const float fb = fbias[o * D + d];
        int te = threadIdx.x;
        asm volatile("" : "+v"(te));
        stage_rows(ug, ug + SEQ, lds, te);
        __syncthreads();
        const bf16_t* stg = (const bf16_t*)lds;
#pragma unroll
        for (int i = 0; i < 16; ++i) {
          const int n = te + 512 * i;
          float gg[2];
#pragma unroll
          for (int b = 0; b < 2; ++b) {
            const bf16_t* ub = stg + b * SEQ + n;
            const float um0 = bf2f(ub[(n > 0) ? -1 : 0]);
            const float uc = bf2f(ub[0]);
            const float up0 = bf2f(ub[(n < SEQ - 1) ? 1 : 0]);
            const float um = (n > 0) ? um0 : 0.f;
            const float up = (n < SEQ - 1) ? up0 : 0.f;
            gg[b] = um * w0 + uc * w1 + up * w2 + bb;
          }
          const float2 xv = xr[i];
          const float z0 = gg[0] * (acc[i].x + xv.x * fb);
          const float z1 = gg[1] * (acc[i].y + xv.y * fb);
          if (o == 0) xr[i] = make_float2(z0, z1);
          else {
            YT[(size_t)d * MALL + n] = f2bf(z0);
            YT[(size_t)d * MALL + SEQ + n] = f2bf(z1);
          }
        }
        __syncthreads();
      }
    } else {
      const int d = it - 1024;
      const int tc = tid_();
      float* Fc = (float*)lds;
      float* zs = Fc + 1024;
      const float* hid = (const float*)(p.ws + OFF_HID3C) + (size_t)j * 256 * 64;
      const float* wout = p.in[23] + (size_t)j * 64 * 4096;
      const float delta = fabsf(-3.0701134573253945f + (float)d * ((-15.350567286626973f + 3.0701134573253945f) / 1023.f));
#pragma unroll
      for (int i = 0; i < 2; ++i) {
        const int idx = tc + 512 * i;
        const int od = idx >> 8, t = idx & 255;
        float s = 0.f;
        for (int h = 0; h < 64; ++h) s += hid[t * 64 + h] * wout[(size_t)h * 4096 + od * 1024 + d];
        Fc[idx] = s * __expf(-(float)t * (1.f / 255.f) * delta);
      }
      const int b = tc >> 8, t = tc & 255;
      float sc3[3];
#pragma unroll
      for (int c3 = 0; c3 < 3; ++c3) {
        const int col = c3 * 1024 + d;
        const bf16_t* ub = U + (size_t)col * MALL + MLAT + b * CTXL + t;
        const float um0 = bf2f(ub[(t > 0) ? -1 : 0]);
        const float uc = bf2f(ub[0]);
        const float up0 = bf2f(ub[(t < CTXL - 1) ? 1 : 0]);
        const float um = (t > 0) ? um0 : 0.f;
        const float up = (t < CTXL - 1) ? up0 : 0.f;
        sc3[c3] = um * cw[col] + uc * cw[3072 + col] + up * cw[6144 + col] + cb[col];
      }
      float zin = sc3[0];
#pragma unroll 1
      for (int o = 0; o < 2; ++o) {
        __syncthreads();
        zs[b * 256 + t] = zin;
        __syncthreads();
        const float* fwd = Fc + (o * 2) * 256;
        const float* bwd = fwd + 256;
        float a = 0.f;
        for (int s = 0; s < 256; ++s) {
          const int dd = t - s;
          const float tap = (dd > 0) ? fwd[dd] : ((dd < 0) ? bwd[-dd] : (fwd[0] + bwd[0]));
          a += tap * zs[b * 256 + s];
        }
        const float res = sc3[1 + o] * (a + zin * fbias[o * D + d]);
        if (o == 0) zin = res;
        else YT[(size_t)d * MALL + MLAT + b * CTXL + t] = f2bf(res);
      }
      __syncthreads();
    }
  }
}

__device__ __forceinline__ void transpose_y_phase(const Params& p, int ntok, char* lds) {
  const int G = gridDim.x, tid = tid_();
  const bf16_t* YT = (const bf16_t*)(p.ws + OFF_YT);
  bf16_t* YB = (bf16_t*)(p.ws + OFF_OB);
  unsigned* T = (unsigned*)lds;
  const int ntt = ntok >> 7;
  const int lane = tid & 63, w = tid >> 6;
  const int ch = lane >> 2, dp = (lane & 3) + 4 * w;
  for (int t = blockIdx.x; t < 16 * ntt; t += G) {
    const int dt = t / ntt, tt = t - dt * ntt;
    {
      const bf16_t* g = YT + (size_t)(dt * 64 + 2 * dp) * MALL + tt * 128 + ch * 8;
      const uint4 a = *(const uint4*)(g);
      const uint4 c = *(const uint4*)(g + MALL);
      unsigned* tp = T + (ch * 8) * 33 + dp;
      tp[0 * 33] = (a.x & 0xffffu) | (c.x << 16);  tp[1 * 33] = (a.x >> 16) | (c.x & 0xffff0000u);
      tp[2 * 33] = (a.y & 0xffffu) | (c.y << 16);  tp[3 * 33] = (a.y >> 16) | (c.y & 0xffff0000u);
      tp[4 * 33] = (a.z & 0xffffu) | (c.z << 16);  tp[5 * 33] = (a.z >> 16) | (c.z & 0xffff0000u);
      tp[6 * 33] = (a.w & 0xffffu) | (c.w << 16);  tp[7 * 33] = (a.w >> 16) | (c.w & 0xffff0000u);
    }
    __syncthreads();
#pragma unroll
    for (int i = 0; i < 2; ++i) {
      const int idx = tid + 512 * i;
      const int tk = idx >> 3, q = idx & 7;
      const unsigned* tp = T + tk * 33 + q * 4;
      uint4 o;
      o.x = tp[0]; o.y = tp[1]; o.z = tp[2]; o.w = tp[3];
      *(uint4*)(YB + (size_t)(tt * 128 + tk) * D + dt * 64 + q * 8) = o;
    }
    __syncthreads();
  }
}

#define XB_TMO      128
#define XB_XCNT(j)  (256  + 64 * (j))
#define XB_XSUB(j)  (1280 + 64 * (j))
#define XB_XGEN(j)  (2304 + 64 * (j))
#define XB_TOP      3328
#define XB_TOPGEN   3392
#define XCD_BAR_WORDS 3456
#define XB_SPIN_CAP (1u << 18)
#define LAS __attribute__((address_space(3)))

__device__ __forceinline__ unsigned xb_ld(unsigned* p)              { return __hip_atomic_load(p, __ATOMIC_RELAXED, __HIP_MEMORY_SCOPE_AGENT); }
__device__ __forceinline__ unsigned xb_add(unsigned* p, unsigned v) { return __hip_atomic_fetch_add(p, v, __ATOMIC_RELAXED, __HIP_MEMORY_SCOPE_AGENT); }
__device__ __forceinline__ unsigned xb_xcc_id() { return (unsigned)__builtin_amdgcn_s_getreg((3 << 11) | 20) & 0xFu; }
#define XB_SPIN(cond, bar) do { unsigned _sp = 0; while (cond) { __builtin_amdgcn_s_sleep(1); \
    if ((++_sp & 255u) == 0u) { if (xb_ld(&(bar)[XB_TMO])) break; if (_sp > XB_SPIN_CAP) { atomicAdd(&(bar)[XB_TMO], 1u); break; } } } } while (0)

struct XcdBarrier {
    unsigned* bar; unsigned x;
    volatile LAS unsigned* st;
};

__device__ __forceinline__ XcdBarrier xcd_barrier_post(unsigned* bar, volatile LAS unsigned* st) {
    XcdBarrier b; b.bar = bar; b.x = xb_xcc_id(); b.st = st;
    if (threadIdx.x == 0) (void)xb_add(&bar[XB_XCNT(b.x)], 1u);
    return b;
}
__device__ __forceinline__ void xcd_barrier_complete(unsigned* bar, unsigned x, unsigned& nloc, unsigned& nx) {
    const unsigned G = gridDim.x * gridDim.y * gridDim.z;
    unsigned sum, cnt, mine, sp = 0u;
    for (;;) {
        sum = 0u; cnt = 0u; mine = 0u;
#pragma unroll
        for (unsigned j = 0; j < 16; ++j) { const unsigned c = xb_ld(&bar[XB_XCNT(j)]); sum += c; cnt += (c > 0u) ? 1u : 0u; mine = (j == x) ? c : mine; }
        if (sum == G) break;
        __builtin_amdgcn_s_sleep(1);
        if ((++sp & 255u) == 0u) { if (xb_ld(&bar[XB_TMO])) break; if (sp > XB_SPIN_CAP) { atomicAdd(&bar[XB_TMO], 1u); break; } }
    }
    nloc = mine > 0u ? mine : 1u; nx = cnt > 0u ? cnt : 1u;
}

__device__ __forceinline__ void xcd_barrier(const XcdBarrier& b) {
    asm volatile("s_waitcnt vmcnt(0)" ::: "memory");
    __syncthreads();
    if (threadIdx.x == 0) {
        unsigned* bar = b.bar;
        __builtin_amdgcn_s_waitcnt(0);
        unsigned nloc = b.st[0], nx = b.st[1];
        if (nloc == 0u) { xcd_barrier_complete(bar, b.x, nloc, nx); b.st[0] = nloc; b.st[1] = nx; }
        const unsigned old = xb_add(&bar[XB_XSUB(b.x)], 1u);
        const unsigned gen = old / nloc;
        if (old + 1u == (gen + 1u) * nloc) {
            __builtin_amdgcn_fence(__ATOMIC_RELEASE, "agent");
            asm volatile("s_waitcnt vmcnt(0)" ::: "memory");
            const unsigned og = xb_add(&bar[XB_TOP], 1u);
            const unsigned tg = og / nx;
            if (og + 1u == (tg + 1u) * nx) xb_add(&bar[XB_TOPGEN], 1u);
            else XB_SPIN(xb_ld(&bar[XB_TOPGEN]) == tg, bar);
            __builtin_amdgcn_fence(__ATOMIC_ACQUIRE, "agent");
            xb_add(&bar[XB_XGEN(b.x)], 1u);
            asm volatile("s_waitcnt vmcnt(0)" ::: "memory");
        } else {
            XB_SPIN(xb_ld(&bar[XB_XGEN(b.x)]) == gen, bar);
            __builtin_amdgcn_fence(__ATOMIC_ACQUIRE, "agent");
            asm volatile("s_waitcnt vmcnt(0)" ::: "memory");
        }
    }
    __syncthreads();
}


__device__ __forceinline__ void grid_barrier(unsigned* ctr, unsigned target) {
  asm volatile("s_waitcnt vmcnt(0)" ::: "memory");
  __syncthreads();
  if (threadIdx.x == 0) {
    __builtin_amdgcn_fence(__ATOMIC_RELEASE, "agent");
    asm volatile("s_waitcnt vmcnt(0)" ::: "memory");
    __hip_atomic_fetch_add(ctr, 1u, __ATOMIC_RELAXED, __HIP_MEMORY_SCOPE_AGENT);
    while (__hip_atomic_load(ctr, __ATOMIC_RELAXED, __HIP_MEMORY_SCOPE_AGENT) < target) __builtin_amdgcn_s_sleep(1);
    __builtin_amdgcn_fence(__ATOMIC_ACQUIRE, "agent");
  }
  __syncthreads();
}

__global__ void __launch_bounds__(NTHR, 2) fwd_megakernel(Params p) {
  extern __shared__ __attribute__((aligned(16))) char lds[];
  cg::grid_group grid = cg::this_grid();
  {
    volatile LAS unsigned* xst = (volatile LAS unsigned*)(lds + 139248);
    if (threadIdx.x < 4) xst[threadIdx.x] = 0u;
    __syncthreads();
  }
  if (blockIdx.x == 0) {
    unsigned* bw = (unsigned*)(p.ws + OFF_BAR);
    for (int i = threadIdx.x; i < 4096; i += NTHR) bw[i] = 0u;
  }
  XcdBarrier xbar;
  xbar.bar = (unsigned*)(p.ws + OFF_BAR); xbar.x = xb_xcc_id(); xbar.st = (volatile LAS unsigned*)(lds + 139248);
  char* ws = p.ws;
  unsigned nbar = 0;
  for (int ph = p.ph_lo; ph < p.ph_hi; ++ph) {
    int ptype = 8;
    if (ph > 0) {
      const int sub_ = (ph - 1) % 10, l_ = (ph - 1) / 10;
      ptype = (sub_ == 0 || sub_ == 3 || sub_ == 7) ? 0 : (sub_ == 1 || sub_ == 8) ? 1 : (sub_ == 2 || sub_ == 9) ? 2 : (sub_ == 6) ? 5 : (sub_ == 4) ? ((l_ & 1) ? 6 : 3) : ((l_ & 1) ? 7 : 4);
    }
    const int nrep = ((PROBE_MASK >> ptype) & 1) ? 2 : 1;
    for (int rep = 0; rep < nrep; ++rep) {
    if (rep > 0) { xcd_barrier(xbar); }
    if (ph == 0) {
      p0_prologue(p, lds);
    } else {
      const int l = (ph - 1) / 10, sub = (ph - 1) % 10;
      const bool is_attn = (l & 1) == 0;
      const int mi2 = l >> 1;
      const int rows = (l < 3) ? MALL : MLAT;
      const int MT = rows / 256;
      const float* MODL = (const float*)(ws + OFF_MOD) + (size_t)l * 3 * 9216;
      Epi e{};
      e.S = (float*)(ws + OFF_S);
      e.Sin = (l == 0 && sub == 2) ? p.in[0] : (const float*)(ws + OFF_S);
      if (sub == 0 || sub == 3 || sub == 7) {
        const int nparts = (sub == 0) ? ((l > 0) ? 11 : 0) : ((l < 3) ? ((sub == 3) ? 11 : 4) : 0);
        normmod_phase(p, l, sub == 0 ? 0 : (sub == 3 ? 1 : 2), rows, nparts);
      } else if (sub == 1 || sub == 8) {
        const int fi = l * 2 + (sub == 8);
        e.ob = (bf16_t*)(ws + OFF_ACT);
        gemm256_phase<EPI_SWIGLU>((const bf16_t*)(ws + OFF_HB), (const bf16_t*)(ws + OFF_WGU) + (size_t)fi * NGU * D, D, D / 64, MT, NGU / 256, lds, e, 0);
      } else if (sub == 2 || sub == 9 || sub == 6) {
        const bf16_t* A; const bf16_t* Bt; int K;
        e.out2 = nullptr; e.bias = nullptr;
        if (sub == 6) {
          if (!is_attn) {
            transpose_y_phase(p, rows, lds);
            xcd_barrier(xbar);
          }
          e.gate = MODL + 5 * D; e.coef = 1.f; K = D;
          A = (const bf16_t*)(ws + OFF_OB);
          if (is_attn) Bt = (const bf16_t*)(ws + OFF_WO) + (size_t)mi2 * D * D;
          else { Bt = (const bf16_t*)(ws + OFF_WHO) + (size_t)mi2 * D * D; e.bias = p.in[27] + (size_t)mi2 * D; }
        } else {
          const int fi = l * 2 + (sub == 9);
          e.gate = MODL + (sub == 2 ? 2 : 8) * D; e.coef = 0.5f; K = FF;
          A = (const bf16_t*)(ws + OFF_ACT);
          Bt = (const bf16_t*)(ws + OFF_WD) + (size_t)fi * D * FF;
          if (l == 3 && sub == 9) e.out2 = p.out;
        }
        if (rep + 1 < nrep) { e.coef = 0.f; e.out2 = nullptr; }
        const int nkt = K / 64;
        const int nlat = 256;
        const int nsplit = (l < 3) ? (nkt / 4) : 0;
        const int total = nlat + 8 * nsplit;
        const int G = gridDim.x;
        int bid = blockIdx.x;
        if ((G & 7) == 0) bid = (bid & 7) * (G >> 3) + (bid >> 3);
        for (int u = bid; u < total; u += G) {
          if (u < nlat) {
            e.atomic = 0;
            const int band = u >> 5, rem = u & 31;
            gemm256_tile<EPI_RESID>(A, Bt, K, 0, nkt, (band * 8 + (rem & 7)) * 256, (rem >> 3) * 256, lds, e, 0);
          } else {
            e.atomic = 1;
            e.part = (float*)(ws + OFF_PART);
            const int it = u - nlat;
            const int part = it >> 3, un = it & 7;
            gemm256_tile<EPI_RESID>(A, Bt, K, part * 4, 4, (64 + (un & 1)) * 256, (un >> 1) * 256, lds, e, part);
          }
        }
      } else if (sub == 4) {
        if (is_attn) {
          e.q = (bf16_t*)(ws + OFF_Q); e.kb = (bf16_t*)(ws + OFF_KB);
          e.qn = p.in[11] + mi2 * 64; e.kn = p.in[12] + mi2 * 64;
          const bf16_t* W = (const bf16_t*)(ws + OFF_WQKV) + (size_t)mi2 * 1536 * D;
          gemm256_phase<EPI_QK>((const bf16_t*)(ws + OFF_HB), W, D, D / 64, MT, 5, lds, e, 0);
          Epi e2{};
          e2.ob = (bf16_t*)(ws + OFF_VT); e2.ldo = NKEY; e2.vmode = 1; e2.bias = nullptr;
          gemm256_phase<EPI_T>(W + (size_t)1280 * D, (const bf16_t*)(ws + OFF_HB), D, D / 64, 1, MT, lds, e2, MT * 5);
        } else {
          Epi e2{};
          e2.ob = (bf16_t*)(ws + OFF_ACT); e2.ldo = MALL; e2.vmode = 0;
          e2.bias = p.in[14] + (size_t)mi2 * 3072;
          gemm256_phase<EPI_T>((const bf16_t*)(ws + OFF_WIN) + (size_t)mi2 * 3072 * D, (const bf16_t*)(ws + OFF_HB), D, D / 64, 12, MT, lds, e2, 0);
          Epi e3{};
          e3.ob = (bf16_t*)(ws + OFF_FILT);
          gemm256_phase<EPI_FILT>((const bf16_t*)(ws + OFF_WOUTT) + (size_t)mi2 * 4096 * 64, (const bf16_t*)(ws + OFF_HID3) + (size_t)mi2 * 8192 * 64, 64, 1, 16, 32, lds, e3, MT * 12);
        }
      } else if (sub == 5) {
        if (is_attn) attention_phase(p, mi2, lds);
        else hyena_conv_phase(p, mi2, l < 3, lds);
      }
    }
    }
    if (ph + 1 < p.ph_hi) {
      if (ph == 0) {
        grid.sync();
        if (threadIdx.x == 0) (void)xb_add(&xbar.bar[XB_XCNT(xbar.x)], 1u);
      }
      else { xcd_barrier(xbar); }
    }
  }
}

constexpr int LDS_BYTES = 139264;
constexpr int NPHASES = 41;

extern "C" void kernel_launch(void* const* d_in, const int* in_sizes, int n_in, void* d_out, int out_size,
                              void* d_ws, size_t ws_size, hipStream_t stream) {
  static int grid_blocks = 0;
  if (grid_blocks == 0) {
    if (ws_size < WS_END) { fprintf(stderr, "kernel_launch: workspace too small: %zu < %zu\n", ws_size, (size_t)WS_END); grid_blocks = -1; return; }
    int dev = 0, cus = 0, per_cu = 0;
    hipGetDevice(&dev);
    hipDeviceGetAttribute(&cus, hipDeviceAttributeMultiprocessorCount, dev);
    if (hipFuncSetAttribute((const void*)fwd_megakernel, hipFuncAttributeMaxDynamicSharedMemorySize, LDS_BYTES) != hipSuccess) {
      fprintf(stderr, "kernel_launch: hipFuncSetAttribute failed\n"); grid_blocks = -1; return;
    }
    hipOccupancyMaxActiveBlocksPerMultiprocessor(&per_cu, (const void*)fwd_megakernel, NTHR, LDS_BYTES);
    if (per_cu < 1) { fprintf(stderr, "kernel_launch: occupancy query says %d blocks/CU\n", per_cu); per_cu = 1; }
    grid_blocks = cus * 1;
    (void)hipGetLastError();
  }
  if (grid_blocks < 0) return;
  Params p{};
  for (int i = 0; i < 28; ++i) p.in[i] = (const float*)d_in[i];
  p.out = (float*)d_out;
  p.ws = (char*)d_ws;
  p.ph_lo = 0;
  p.ph_hi = NPHASES;
  void* args[] = {&p};
  hipError_t e = hipLaunchCooperativeKernel((const void*)fwd_megakernel, dim3(grid_blocks), dim3(NTHR), args, LDS_BYTES, stream);
  if (e != hipSuccess) fprintf(stderr, "cooperative launch failed: %s (grid %d)\n", hipGetErrorString(e), grid_blocks);
}
```
